# Optimizing an MI355X kernel written in HIP

```python
import math
import jax
import jax.numpy as jnp
from jax import lax
import numpy as np

D_MODEL = 1024
BATCH = 1
SEQ = 16384
DEPTH = 2

GRID_W = 64
CTX_LEN = 256
HEAD_DIM = 64
Q_BLOCK = 128
EPS = 1e-6
ROPE_THETA = 10000.0
D_FF = 2816
ADA_STD = 0.02
N_MOD = 9

A_HEADS = 8
A_KV_HEADS = 2
B_HEADS = 8
B_NOPE = 64
B_ROPE = 32
B_VDIM = 64
B_KV_RANK = 256
B_QK = B_NOPE + B_ROPE
C_HEADS = 8
C_DK = 64
C_DV = 64
C_CHUNK = 64
D_HEADS = 8
D_WIN_H = 8
D_WIN_W = 16

N_EVEN = (DEPTH + 1) // 2
N_ODD = DEPTH // 2

A_QW = A_HEADS * HEAD_DIM
A_KVW = A_KV_HEADS * HEAD_DIM
B_QW = B_HEADS * B_QK
AB_IN = A_QW + 2 * A_KVW + B_QW + B_KV_RANK + B_ROPE
AB_SPLITS = (A_QW, A_QW + A_KVW, A_QW + 2 * A_KVW, A_QW + 2 * A_KVW + B_QW, A_QW + 2 * A_KVW + B_QW + B_KV_RANK)
AB_OUT = A_QW + B_HEADS * B_VDIM

C_W = C_HEADS * C_DK
C_VW = C_HEADS * C_DV
D_W = D_HEADS * HEAD_DIM
CD_IN = 3 * C_W + 2 * C_VW + 3 * D_W
CD_SPLITS = (C_W, 2 * C_W, 3 * C_W, 3 * C_W + C_VW, 3 * C_W + 2 * C_VW, 3 * C_W + 2 * C_VW + D_W, 3 * C_W + 2 * C_VW + 2 * D_W)
CD_OUT = C_VW + D_W

kernel_name = 'hybrid_dit_gqa_mla_hgrn2_natten'


def rms_norm(x, g):
    xf = x.astype(jnp.float32)
    y = xf * lax.rsqrt(jnp.mean(xf * xf, axis=-1, keepdims=True) + EPS)
    return (y * g.astype(jnp.float32)).astype(x.dtype)


def modulate(h, shift, scale):
    return h * (1 + scale[:, None, :]) + shift[:, None, :]


def swiglu(h, w1, w3, w2):
    return (jax.nn.silu(h @ w1) * (h @ w3)) @ w2


def half_ffn(h, g, shift, scale, gate, w1, w3, w2):
    return h + 0.5 * gate[:, None, :] * swiglu(modulate(rms_norm(h, g), shift, scale), w1, w3, w2)


def rope_1d(pos, dim):
    inv = ROPE_THETA ** (-jnp.arange(0, dim, 2, dtype=jnp.float32) / dim)
    ang = pos.astype(jnp.float32)[:, None] * inv[None, :]
    ang = jnp.concatenate([ang, ang], axis=-1)
    return jnp.cos(ang), jnp.sin(ang)


def axial_rope_tables(n_tok, dim):
    t = jnp.arange(n_tok, dtype=jnp.int32)
    cos_r, sin_r = rope_1d(t // GRID_W, dim // 2)
    cos_c, sin_c = rope_1d(t % GRID_W, dim // 2)
    return jnp.concatenate([cos_r, cos_c], axis=-1), jnp.concatenate([sin_r, sin_c], axis=-1)


def _rotate_half(u):
    u1, u2 = jnp.split(u, 2, axis=-1)
    return jnp.concatenate([-u2, u1], axis=-1)


def apply_axial_rope(x, cos, sin):
    h = x.shape[-1] // 2
    rot = jnp.concatenate([_rotate_half(x[..., :h]), _rotate_half(x[..., h:])], axis=-1)
    return x * cos[None, :, None, :].astype(x.dtype) + rot * sin[None, :, None, :].astype(x.dtype)


def blocked_attention(q, k, v, scale):
    b, s, hkv, g, d = q.shape
    nb = s // Q_BLOCK
    qb = jnp.moveaxis(q.reshape(b, nb, Q_BLOCK, hkv, g, d), 1, 0)

    def one_block(qi):
        sc = jnp.einsum('bqhgd,bkhd->bhgqk', qi, k, preferred_element_type=jnp.float32) * scale
        p = jax.nn.softmax(sc, axis=-1).astype(v.dtype)
        return jnp.einsum('bhgqk,bkhd->bqhgd', p, v)

    out = lax.map(one_block, qb)
    return jnp.moveaxis(out, 0, 1).reshape(b, s, hkv * g * v.shape[-1])


def mixer_ab(hx, hc, w_in, a_qn, a_kn, b_qn, b_kn, b_kvn, b_wukv, w_out, with_ctx):
    b, s, _ = hx.shape
    grp = A_HEADS // A_KV_HEADS
    cos_a, sin_a = axial_rope_tables(s, HEAD_DIM)
    cos_b, sin_b = axial_rope_tables(s, B_ROPE)

    def project(h, rotary):
        n = h.shape[1]
        aq, ak, av, bq, bkv, bkr = jnp.split(h @ w_in, AB_SPLITS, axis=-1)
        aq = rms_norm(aq.reshape(b, n, A_HEADS, HEAD_DIM), a_qn)
        ak = rms_norm(ak.reshape(b, n, A_KV_HEADS, HEAD_DIM), a_kn)
        av = av.reshape(b, n, A_KV_HEADS, HEAD_DIM)
        kv = (rms_norm(bkv, b_kvn) @ b_wukv).reshape(b, n, B_HEADS, B_NOPE + B_VDIM)
        bk_rope = jnp.broadcast_to(bkr[:, :, None, :], (b, n, B_HEADS, B_ROPE))
        bq = rms_norm(bq.reshape(b, n, B_HEADS, B_QK), b_qn)
        bk = rms_norm(jnp.concatenate([kv[..., :B_NOPE], bk_rope], axis=-1), b_kn)
        bv = kv[..., B_NOPE:]
        if rotary:
            aq = apply_axial_rope(aq, cos_a, sin_a)
            ak = apply_axial_rope(ak, cos_a, sin_a)
            bq = jnp.concatenate([bq[..., :B_NOPE], apply_axial_rope(bq[..., B_NOPE:], cos_b, sin_b)], axis=-1)
            bk = jnp.concatenate([bk[..., :B_NOPE], apply_axial_rope(bk[..., B_NOPE:], cos_b, sin_b)], axis=-1)
        return aq.reshape(b, n, A_KV_HEADS, grp, HEAD_DIM), ak, av, bq[:, :, :, None, :], bk, bv

    qa, ka, va, qb, kb, vb = project(hx, True)
    qa_c, ka_c, va_c, qb_c, kb_c, vb_c = project(hc, False)
    y_x = jnp.concatenate([
        blocked_attention(qa, jnp.concatenate([ka, ka_c], axis=1), jnp.concatenate([va, va_c], axis=1), HEAD_DIM ** -0.5),
        blocked_attention(qb, jnp.concatenate([kb, kb_c], axis=1), jnp.concatenate([vb, vb_c], axis=1), B_QK ** -0.5),
    ], axis=-1) @ w_out
    if not with_ctx:
        return y_x, None
    y_c = jnp.concatenate([
        blocked_attention(qa_c, ka_c, va_c, HEAD_DIM ** -0.5),
        blocked_attention(qb_c, kb_c, vb_c, B_QK ** -0.5),
    ], axis=-1) @ w_out
    return y_x, y_c


def hgrn_chunk_scan(q, k, v, g, s0, with_output):
    b, h, n, dk = q.shape
    nc = n // C_CHUNK

    def chunks(t):
        return jnp.moveaxis(t.reshape(b, h, nc, C_CHUNK, t.shape[-1]), 2, 0)

    tri = jnp.tril(jnp.ones((C_CHUNK, C_CHUNK), dtype=bool))[:, :, None]

    def step(state, inp):
        qi, ki, vi, gi = inp
        gcum = jnp.cumsum(gi, axis=2)
        glast = gcum[:, :, -1, :]
        new_state = jnp.exp(glast)[..., None] * state + jnp.einsum('bhck,bhcv->bhkv', ki * jnp.exp(glast[:, :, None, :] - gcum), vi)
        if not with_output:
            return new_state, None
        o_inter = jnp.einsum('bhtk,bhkv->bhtv', qi * jnp.exp(gcum), state)
        decay = jnp.exp(jnp.where(tri, gcum[:, :, :, None, :] - gcum[:, :, None, :, :], -jnp.inf))
        attn = jnp.einsum('bhtk,bhsk,bhtsk->bhts', qi, ki, decay)
        return new_state, o_inter + jnp.einsum('bhts,bhsv->bhtv', attn, vi)

    s_fin, o = lax.scan(step, s0, (chunks(q), chunks(k), chunks(v), chunks(g)))
    if with_output:
        o = jnp.moveaxis(o, 0, 2).reshape(b, h, n, v.shape[-1])
    return s_fin, o


def neighbourhood_attention(q, k, v, k_ctx, v_ctx, rpb):
    b, s, h, d = q.shape
    rows = s // GRID_W
    kh = min(D_WIN_H, rows)
    kw = D_WIN_W
    n_win = kh * kw
    cols = np.arange(GRID_W)
    col_idx = np.clip(cols - kw // 2, 0, GRID_W - kw)[:, None] + np.arange(kw)[None, :]
    col_rel = col_idx - cols[:, None] + (D_WIN_W - 1)
    rpb_cols = rpb[:, :, col_rel]
    kg = k.reshape(b, rows, GRID_W, h, d)
    vg = v.reshape(b, rows, GRID_W, h, d)
    q_rows = jnp.moveaxis(q.reshape(b, rows, GRID_W, h, d), 1, 0)
    scale = d ** -0.5

    def one_row(args):
        r, q_row = args
        rs = jnp.clip(r - kh // 2, 0, rows - kh)
        k_win = lax.dynamic_slice_in_dim(kg, rs, kh, axis=1)[:, :, col_idx]
        v_win = lax.dynamic_slice_in_dim(vg, rs, kh, axis=1)[:, :, col_idx]
        row_rel = rs + jnp.arange(kh) - r + (D_WIN_H - 1)
        bias = jnp.transpose(jnp.take(rpb_cols, row_rel, axis=1), (0, 2, 1, 3))
        s_win = jnp.einsum('bchd,brcwhd->bhcrw', q_row, k_win, preferred_element_type=jnp.float32) * scale + bias[None].astype(jnp.float32)
        s_ctx = jnp.einsum('bchd,bnhd->bhcn', q_row, k_ctx, preferred_element_type=jnp.float32) * scale
        p = jax.nn.softmax(jnp.concatenate([s_win.reshape(b, h, GRID_W, n_win), s_ctx], axis=-1), axis=-1).astype(v.dtype)
        return (jnp.einsum('bhcrw,brcwhd->bchd', p[..., :n_win].reshape(b, h, GRID_W, kh, kw), v_win)
                + jnp.einsum('bhcn,bnhd->bchd', p[..., n_win:], v_ctx))

    out = lax.map(one_row, (jnp.arange(rows, dtype=jnp.int32), q_rows))
    return jnp.moveaxis(out, 0, 1).reshape(b, s, h * d)


def mixer_cd(hx, hc, w_in, lb, c_gn, d_qn, d_kn, d_rpb, w_out, with_ctx):
    b, s, _ = hx.shape
    f32 = jnp.float32
    px = jnp.split(hx @ w_in, CD_SPLITS, axis=-1)
    pc = jnp.split(hc @ w_in, CD_SPLITS, axis=-1)

    def heads_first(t, dh):
        return jnp.moveaxis(t.reshape(b, t.shape[1], -1, dh), 2, 1)

    def hgrn_inputs(p, direction):
        z = p[1 + direction].astype(f32)
        lbd = lb[direction]
        logf = jnp.logaddexp(jnp.log(lbd), jnp.log1p(-lbd) + jax.nn.log_sigmoid(z))
        key_in = -jnp.expm1(logf)
        t = (heads_first(jax.nn.silu(p[0].astype(f32)), C_DK), heads_first(key_in, C_DK),
             heads_first(p[3].astype(f32), C_DV), heads_first(logf, C_DK))
        if direction == 1:
            t = tuple(jnp.flip(u, axis=2) for u in t)
        return t

    def hgrn_out(o, p):
        o = jnp.moveaxis(o, 1, 2)
        n = o.shape[1]
        gate = p[4].reshape(b, n, C_HEADS, C_DV)
        return (rms_norm(o, c_gn).astype(gate.dtype) * jax.nn.silu(gate)).reshape(b, n, C_VW)

    s0 = jnp.zeros((b, C_HEADS, C_DK, C_DV), f32)
    qf, kf, vf, gf = hgrn_inputs(pc, 0)
    s_cf, o_cf = hgrn_chunk_scan(qf, kf, vf, gf, s0, with_ctx)
    qf, kf, vf, gf = hgrn_inputs(px, 0)
    _, o_xf = hgrn_chunk_scan(qf, kf, vf, gf, s_cf, True)
    qb_, kb_, vb_, gb_ = hgrn_inputs(pc, 1)
    s_cb, o_cb = hgrn_chunk_scan(qb_, kb_, vb_, gb_, s0, with_ctx)
    qb_, kb_, vb_, gb_ = hgrn_inputs(px, 1)
    _, o_xb = hgrn_chunk_scan(qb_, kb_, vb_, gb_, s_cb, True)
    o_lat = o_xf + jnp.flip(o_xb, axis=2)

    def d_qkv(p):
        n = p[5].shape[1]
        return (rms_norm(p[5].reshape(b, n, D_HEADS, HEAD_DIM), d_qn),
                rms_norm(p[6].reshape(b, n, D_HEADS, HEAD_DIM), d_kn),
                p[7].reshape(b, n, D_HEADS, HEAD_DIM))

    dq, dk, dv = d_qkv(px)
    dq_c, dk_c, dv_c = d_qkv(pc)
    y_x = jnp.concatenate([hgrn_out(o_lat, px), neighbourhood_attention(dq, dk, dv, dk_c, dv_c, d_rpb)], axis=-1) @ w_out
    if not with_ctx:
        return y_x, None
    o_ctx = o_cf + jnp.flip(o_cb, axis=2)
    y_c = jnp.concatenate([hgrn_out(o_ctx, pc), blocked_attention(dq_c[:, :, :, None, :], dk_c, dv_c, HEAD_DIM ** -0.5)], axis=-1) @ w_out
    return y_x, y_c


def setup_inputs(seed: int = 0) -> dict:
    key = jax.random.key(seed)
    ks = jax.random.split(key, 26)

    def nrm(k, shape, scale):
        return jax.random.normal(k, shape, jnp.float32) * scale

    def gain(k, shape):
        return 1.0 + 0.05 * jax.random.normal(k, shape, jnp.float32)

    return {
        'x': nrm(ks[0], (BATCH, SEQ, D_MODEL), 1.0),
        'c': nrm(ks[1], (BATCH, D_MODEL), 1.0),
        'ctx': nrm(ks[2], (BATCH, CTX_LEN, D_MODEL), 1.0),
        'c_ctx': nrm(ks[3], (D_MODEL,), 1.0),
        'norm_g': gain(ks[4], (DEPTH, 3, D_MODEL)),
        'ada_w': nrm(ks[5], (DEPTH, D_MODEL, N_MOD * D_MODEL), ADA_STD),
        'ada_b': nrm(ks[6], (DEPTH, N_MOD * D_MODEL), 0.02),
        'ffn_w1': nrm(ks[7], (DEPTH, 2, D_MODEL, D_FF), D_MODEL ** -0.5),
        'ffn_w3': nrm(ks[8], (DEPTH, 2, D_MODEL, D_FF), D_MODEL ** -0.5),
        'ffn_w2': nrm(ks[9], (DEPTH, 2, D_FF, D_MODEL), D_FF ** -0.5),
        'ab_w_in': nrm(ks[10], (N_EVEN, D_MODEL, AB_IN), D_MODEL ** -0.5),
        'ab_a_qn': gain(ks[11], (N_EVEN, HEAD_DIM)),
        'ab_a_kn': gain(ks[12], (N_EVEN, HEAD_DIM)),
        'ab_b_qn': gain(ks[13], (N_EVEN, B_QK)),
        'ab_b_kn': gain(ks[14], (N_EVEN, B_QK)),
        'ab_b_kvn': gain(ks[15], (N_EVEN, B_KV_RANK)),
        'ab_b_wukv': nrm(ks[16], (N_EVEN, B_KV_RANK, B_HEADS * (B_NOPE + B_VDIM)), B_KV_RANK ** -0.5),
        'ab_w_out': nrm(ks[17], (N_EVEN, AB_OUT, D_MODEL), AB_OUT ** -0.5),
        'cd_w_in': nrm(ks[18], (N_ODD, D_MODEL, CD_IN), D_MODEL ** -0.5),
        'hgrn_lb': nrm(ks[19], (DEPTH, 2, C_W), 0.5),
        'cd_c_gn': gain(ks[20], (N_ODD, C_DV)),
        'cd_d_qn': gain(ks[21], (N_ODD, HEAD_DIM)),
        'cd_d_kn': gain(ks[22], (N_ODD, HEAD_DIM)),
        'cd_d_rpb': nrm(ks[23], (N_ODD, D_HEADS, 2 * D_WIN_H - 1, 2 * D_WIN_W - 1), 0.5),
        'cd_w_out': nrm(ks[24], (N_ODD, CD_OUT, D_MODEL), CD_OUT ** -0.5),
    }


def reference(x, c, ctx, c_ctx, norm_g, ada_w, ada_b, ffn_w1, ffn_w3, ffn_w2, ab_w_in, ab_a_qn, ab_a_kn, ab_b_qn, ab_b_kn, ab_b_kvn, ab_b_wukv, ab_w_out, cd_w_in, hgrn_lb, cd_c_gn, cd_d_qn, cd_d_kn, cd_d_rpb, cd_w_out):
    lb_all = jnp.cumsum(jax.nn.softmax(hgrn_lb.astype(jnp.float32), axis=0), axis=0)
    lb_all = lb_all - lb_all[:1]
    for l in range(DEPTH):
        last = l == DEPTH - 1
        i = l // 2
        mod_x = jnp.split(jax.nn.silu(c) @ ada_w[l] + ada_b[l], N_MOD, axis=-1)
        mod_c = jnp.split(jax.nn.silu(c_ctx)[None, :] @ ada_w[l] + ada_b[l], N_MOD, axis=-1)
        x = half_ffn(x, norm_g[l, 0], mod_x[0], mod_x[1], mod_x[2], ffn_w1[l, 0], ffn_w3[l, 0], ffn_w2[l, 0])
        ctx = half_ffn(ctx, norm_g[l, 0], mod_c[0], mod_c[1], mod_c[2], ffn_w1[l, 0], ffn_w3[l, 0], ffn_w2[l, 0])
        hx = modulate(rms_norm(x, norm_g[l, 1]), mod_x[3], mod_x[4])
        hc = modulate(rms_norm(ctx, norm_g[l, 1]), mod_c[3], mod_c[4])
        if l % 2 == 0:
            y_x, y_c = mixer_ab(hx, hc, ab_w_in[i], ab_a_qn[i], ab_a_kn[i], ab_b_qn[i], ab_b_kn[i], ab_b_kvn[i], ab_b_wukv[i], ab_w_out[i], not last)
        else:
            y_x, y_c = mixer_cd(hx, hc, cd_w_in[i], lb_all[l], cd_c_gn[i], cd_d_qn[i], cd_d_kn[i], cd_d_rpb[i], cd_w_out[i], not last)
        x = x + mod_x[5][:, None, :] * y_x
        x = half_ffn(x, norm_g[l, 2], mod_x[6], mod_x[7], mod_x[8], ffn_w1[l, 1], ffn_w3[l, 1], ffn_w2[l, 1])
        if not last:
            ctx = ctx + mod_c[5][:, None, :] * y_c
            ctx = half_ffn(ctx, norm_g[l, 2], mod_c[6], mod_c[7], mod_c[8], ffn_w1[l, 1], ffn_w3[l, 1], ffn_w2[l, 1])
    return x
```

```cpp
#include <hip/hip_runtime.h>
#include <hip/hip_cooperative_groups.h>
#include <cstdio>
#include <cstdint>
namespace cg = cooperative_groups;
#ifndef NAIVE_ATTN
#define NAIVE_ATTN 0
#endif
#ifndef NAIVE_MIX
#define NAIVE_MIX 0
#endif
#ifndef N_LAUNCH_MODE
#define N_LAUNCH_MODE 0
#endif
namespace pg8 {
#define PG8_LAS __attribute__((address_space(3)))
typedef unsigned short bf16_t;
typedef short bf16x8 __attribute__((ext_vector_type(8)));
typedef float f32x4 __attribute__((ext_vector_type(4)));
typedef unsigned u32x4 __attribute__((ext_vector_type(4)));
typedef unsigned u32x2 __attribute__((ext_vector_type(2)));
constexpr int BM = 256, BK = 64, HALF = 128, HTB = HALF * BK * 2, STAGE_BYTES = 8 * HTB, NXCD = 8, WGM = 8;
__host__ __device__ __forceinline__ int lds_byte(int r, int c) { const int st = (r >> 4) * 2 + (c >> 5), rr = r & 15, cc = c & 31, ob = rr * 64 + cc * 2; return st * 1024 + (ob ^ (((ob >> 9) & 1) << 5)); }
__host__ __device__ __forceinline__ void stage_rc(int b, int& R, int& C) { const int st = b / 1024, sb = b % 1024, swz = sb ^ (((sb >> 9) & 1) << 5); R = (st >> 1) * 16 + swz / 64; C = (st & 1) * 32 + (swz % 64) / 2; }
__host__ __device__ __forceinline__ int perm32(int rho) { const int n = rho >> 4, i = rho & 15; return 8 * (i >> 2) + 4 * n + (i & 3); }
struct Unit { int pm, pn; };
struct Gemm { const bf16_t* A; const bf16_t* Bt; int M, N, K, ld; };
struct StaticOrder {
    int nM, nN, nwg, G, c;
    __host__ __device__ void init(int M, int N, int G_, int c_) { nM = M / BM; nN = N / BM; nwg = nM * nN; G = G_; c = c_; }
    __host__ __device__ bool next(int i, Unit& u) const {
        const long L = (long)i * G + c; if (L >= nwg) return false;
        int wgid = (int)L; { const int q = nwg / NXCD, r = nwg % NXCD, xcd = wgid % NXCD, off = wgid / NXCD; wgid = (xcd < r ? xcd * (q + 1) : r * (q + 1) + (xcd - r) * q) + off; }
        const int nig = WGM * nN, gid = wgid / nig, fm = gid * WGM, gsz = (nM - fm) < WGM ? (nM - fm) : WGM;
        u.pm = fm + ((wgid % nig) % gsz); u.pn = (wgid % nig) / gsz; return true;
    }
    __device__ __forceinline__ void a_ready(const Unit&) const {}
    __device__ __forceinline__ void done(const Unit&) const {}
};
__device__ __forceinline__ unsigned cvt_pk_bf16(float lo, float hi) { unsigned r; asm volatile("v_cvt_pk_bf16_f32 %0, %1, %2" : "=v"(r) : "v"(lo), "v"(hi)); return r; }
__device__ __forceinline__ float silu_f(float x) { return x * __builtin_amdgcn_rcpf(1.0f + __expf(-x)); }

struct EpiSwiglu {
    static constexpr bool PERM = true, AFTER_DRAIN = false;
    bf16_t* U; int ldu;
    __device__ __forceinline__ void operator()(const f32x4 (&acc)[2][2][4][2], const Unit& u, int wr, int wc, int fr, int fq) const {
        const int row0 = u.pm * BM + wr * 64 + fr, ff0 = u.pn * 128 + wc * 32 + 8 * fq;
#pragma unroll
        for (int ai = 0; ai < 2; ++ai)
#pragma unroll
            for (int m = 0; m < 4; ++m) { bf16_t* rowp = U + (size_t)(row0 + ai * HALF + m * 16) * ldu + ff0;
                const f32x4 a0 = acc[ai][0][m][0], a1 = acc[ai][0][m][1], b0 = acc[ai][1][m][0], b1 = acc[ai][1][m][1];
                u32x4 w; w.x = cvt_pk_bf16(silu_f(a0[0]) * b0[0], silu_f(a0[1]) * b0[1]); w.y = cvt_pk_bf16(silu_f(a0[2]) * b0[2], silu_f(a0[3]) * b0[3]);
                w.z = cvt_pk_bf16(silu_f(a1[0]) * b1[0], silu_f(a1[1]) * b1[1]); w.w = cvt_pk_bf16(silu_f(a1[2]) * b1[2], silu_f(a1[3]) * b1[3]);
                *(u32x4*)rowp = w; }
    }
};
struct EpiResidual {
    static constexpr bool PERM = true, AFTER_DRAIN = false;
    const float* baseL; const float* baseC; float* outL; float* outC; const float* coefL; const float* coefC; float mult;
    __device__ __forceinline__ void operator()(const f32x4 (&acc)[2][2][4][2], const Unit& u, int wr, int wc, int fr, int fq) const {
        const bool isC = u.pm >= 64;
        const float* base = isC ? baseC : baseL; float* out = isC ? outC : outL; const float* coef = isC ? coefC : coefL;
        const int row0 = (isC ? (u.pm - 64) : u.pm) * BM + wr * 64 + fr, col0 = u.pn * BM + wc * 32 + 8 * fq;
        f32x4 cf[2][2];
#pragma unroll
        for (int bj = 0; bj < 2; ++bj)
#pragma unroll
            for (int n = 0; n < 2; ++n) cf[bj][n] = *(const f32x4*)(coef + col0 + bj * HALF + 4 * n) * mult;
#pragma unroll
        for (int ai = 0; ai < 2; ++ai)
#pragma unroll
            for (int m = 0; m < 4; ++m) { const size_t off = (size_t)(row0 + ai * HALF + m * 16) * 1024 + col0;
#pragma unroll
                for (int bj = 0; bj < 2; ++bj)
#pragma unroll
                    for (int n = 0; n < 2; ++n) { const f32x4 b = *(const f32x4*)(base + off + bj * HALF + 4 * n);
                        *(f32x4*)(out + off + bj * HALF + 4 * n) = b + cf[bj][n] * acc[ai][bj][m][n]; } }
    }
};
struct EpiPartCtx {
    static constexpr bool PERM = true, AFTER_DRAIN = false;
    float* part; const float* coef; float mult;
    __device__ __forceinline__ void operator()(const f32x4 (&acc)[2][2][4][2], const Unit& u, int wr, int wc, int fr, int fq) const {
        const int row0 = wr * 64 + fr, col0 = u.pn * BM + wc * 32 + 8 * fq;
        f32x4 cf[2][2];
#pragma unroll
        for (int bj = 0; bj < 2; ++bj)
#pragma unroll
            for (int n = 0; n < 2; ++n) cf[bj][n] = *(const f32x4*)(coef + col0 + bj * HALF + 4 * n) * mult;
#pragma unroll
        for (int ai = 0; ai < 2; ++ai)
#pragma unroll
            for (int m = 0; m < 4; ++m) { float* rp = part + (size_t)(row0 + ai * HALF + m * 16) * 1024 + col0;
#pragma unroll
                for (int bj = 0; bj < 2; ++bj)
#pragma unroll
                    for (int n = 0; n < 2; ++n) *(f32x4*)(rp + bj * HALF + 4 * n) = cf[bj][n] * acc[ai][bj][m][n]; }
    }
};
struct OneUnitOrder {
    int c, n;
    __device__ __forceinline__ bool next(int i, Unit& u) const { if (i > 0 || c >= n) return false; u.pm = 0; u.pn = c & 3; return true; }
    __device__ __forceinline__ void a_ready(const Unit&) const {}
    __device__ __forceinline__ void done(const Unit&) const {}
};
struct EpiStoreBf16 {
    static constexpr bool PERM = true, AFTER_DRAIN = false;
    bf16_t* O; int ldc;
    __device__ __forceinline__ void operator()(const f32x4 (&acc)[2][2][4][2], const Unit& u, int wr, int wc, int fr, int fq) const {
        const int row0 = u.pm * BM + wr * 64 + fr, col0 = u.pn * BM + wc * 32 + 8 * fq;
#pragma unroll
        for (int ai = 0; ai < 2; ++ai)
#pragma unroll
            for (int m = 0; m < 4; ++m) { bf16_t* rowp = O + (size_t)(row0 + ai * HALF + m * 16) * ldc + col0;
#pragma unroll
                for (int bj = 0; bj < 2; ++bj) { const f32x4 v0 = acc[ai][bj][m][0], v1 = acc[ai][bj][m][1];
                    u32x4 w; w.x = cvt_pk_bf16(v0[0], v0[1]); w.y = cvt_pk_bf16(v0[2], v0[3]); w.z = cvt_pk_bf16(v1[0], v1[1]); w.w = cvt_pk_bf16(v1[2], v1[3]);
                    *(u32x4*)(rowp + bj * HALF) = w; } }
    }
};
template <class Epi, class Sched, bool ALIGN_EPI = false, bool SP2 = false>
__device__ __forceinline__ void gemm_phase(PG8_LAS unsigned char* lds, const Gemm g, const Sched& S, const Epi& E, const int tid) {
    const int wid = __builtin_amdgcn_readfirstlane(tid >> 6), lane = tid & 63, wr = wid >> 2, wc = wid & 3, fr = lane & 15, fq = lane >> 4;
    const int K = g.K, nt = K / BK;
    unsigned voffA[2], voffB[2];
#pragma unroll
    for (int i = 0; i < 2; ++i) { int R, C; stage_rc(tid * 16 + i * 8192, R, C); const int Rb = Epi::PERM ? ((R & ~31) + perm32(R & 31)) : R;
        voffA[i] = (unsigned)(R * g.ld + C) * 2u; voffB[i] = (unsigned)(Rb * g.ld + C) * 2u; }
    const size_t kstep = (size_t)(BK * 2);
    const size_t hstep = (size_t)HALF * g.ld * 2;
    const size_t tstep = 2 * hstep;
    const unsigned ldsw = (unsigned)wid * 1024u;
    const int aoff = lds_byte(wr * 64 + fr, fq * 8), boff = lds_byte(wc * 32 + fr, fq * 8);
#define PG8_SA(b, h) (((b) * 2 + (h)) * HTB)
#define PG8_SB(b, h) ((4 + (b) * 2 + (h)) * HTB)
#define PG8_STAGE(bufoff, gbase, voff) do { _Pragma("unroll") for (int _i = 0; _i < 2; ++_i) \
        __builtin_amdgcn_global_load_lds((const unsigned*)((const char*)(gbase) + (voff)[_i]), (PG8_LAS unsigned*)(lds + (bufoff) + ldsw + _i * 8192), 16, 0, 0); } while (0)
#define PG8_LDA(dst, b, h) do { _Pragma("unroll") for (int m = 0; m < 4; ++m) _Pragma("unroll") for (int k = 0; k < 2; ++k) dst[m][k] = *(const PG8_LAS bf16x8*)(lds + PG8_SA(b, h) + aoff + m * 2048 + k * 1024); } while (0)
#define PG8_LDB(dst, b, h) do { _Pragma("unroll") for (int n = 0; n < 2; ++n) _Pragma("unroll") for (int k = 0; k < 2; ++k) dst[n][k] = *(const PG8_LAS bf16x8*)(lds + PG8_SB(b, h) + boff + n * 2048 + k * 1024); } while (0)
#define PG8_MMA(ai, bj, At, Bt) do { __builtin_amdgcn_s_setprio(1); _Pragma("unroll") for (int m = 0; m < 4; ++m) _Pragma("unroll") for (int n = 0; n < 2; ++n) _Pragma("unroll") for (int k = 0; k < 2; ++k) \
        acc[ai][bj][m][n] = __builtin_amdgcn_mfma_f32_16x16x32_bf16(Bt[n][k], At[m][k], acc[ai][bj][m][n], 0, 0, 0); __builtin_amdgcn_s_setprio(0); } while (0)
#define PG8_WAIT_V(n) asm volatile("s_waitcnt vmcnt(" #n ")" ::: "memory")
#define PG8_WAIT_L(n) asm volatile("s_waitcnt lgkmcnt(" #n ")" ::: "memory")
#define PG8_BAR __builtin_amdgcn_s_barrier()
#define PG8_SCHED __builtin_amdgcn_sched_barrier(0)
    Unit cur, nxt; int ui = 0;
    if (!S.next(0, cur)) return;
    f32x4 acc[2][2][4][2];
#pragma unroll
    for (int a = 0; a < 2; ++a)
#pragma unroll
        for (int b = 0; b < 2; ++b)
#pragma unroll
            for (int m = 0; m < 4; ++m)
#pragma unroll
                for (int n = 0; n < 2; ++n) acc[a][b][m][n] = (f32x4){0.f, 0.f, 0.f, 0.f};
    bf16x8 At[4][2], B0[2][2], B1[2][2];
    const char* cA = (const char*)g.A + (size_t)cur.pm * tstep; const char* cB = (const char*)g.Bt + (size_t)cur.pn * tstep;
    S.a_ready(cur);
    if constexpr (SP2) {
        PG8_STAGE(PG8_SB(0, 0), cB, voffB); PG8_STAGE(PG8_SB(0, 1), cB + hstep, voffB); PG8_STAGE(PG8_SA(0, 0), cA, voffA); PG8_STAGE(PG8_SA(0, 1), cA + hstep, voffA);
        if (wr == 1) PG8_BAR;
        PG8_WAIT_V(2); PG8_BAR;
        PG8_STAGE(PG8_SB(1, 0), cB + kstep, voffB); PG8_STAGE(PG8_SA(1, 0), cA + kstep, voffA); PG8_STAGE(PG8_SB(1, 1), cB + hstep + kstep, voffB);
        PG8_WAIT_V(6); PG8_BAR;
    } else {
        PG8_STAGE(PG8_SB(0, 0), cB, voffB); PG8_STAGE(PG8_SA(0, 0), cA, voffA); PG8_STAGE(PG8_SB(0, 1), cB + hstep, voffB); PG8_STAGE(PG8_SA(0, 1), cA + hstep, voffA);
        if (wr == 1) PG8_BAR;
        PG8_WAIT_V(4); PG8_BAR;
        PG8_STAGE(PG8_SB(1, 0), cB + kstep, voffB); PG8_STAGE(PG8_SA(1, 0), cA + kstep, voffA); PG8_STAGE(PG8_SB(1, 1), cB + hstep + kstep, voffB);
        PG8_WAIT_V(6); PG8_BAR;
    }
    for (;;) {
        const bool has_next = S.next(ui + 1, nxt);
        const char* nA = has_next ? (const char*)g.A + (size_t)nxt.pm * tstep : cA; const char* nB = has_next ? (const char*)g.Bt + (size_t)nxt.pn * tstep : cB;
        for (int t = 0; t < nt; t += 2) {
            const bool last = (t == nt - 2);
            const char* a1 = cA + (size_t)(t + 1) * kstep;
            const char* a2 = last ? nA : cA + (size_t)(t + 2) * kstep; const char* b2 = last ? nB : cB + (size_t)(t + 2) * kstep;
            const char* a3 = a2 + kstep; const char* b3 = b2 + kstep;
            if (last && has_next) S.a_ready(nxt);
            if constexpr (SP2) {
            PG8_LDB(B0, 0, 0); PG8_LDB(B1, 0, 1); PG8_SCHED; PG8_LDA(At, 0, 0); PG8_STAGE(PG8_SA(1, 1), a1 + hstep, voffA);
            PG8_WAIT_V(8); PG8_WAIT_L(0); PG8_BAR; PG8_MMA(0, 0, At, B0); PG8_MMA(0, 1, At, B1); PG8_BAR; PG8_SCHED;
            PG8_LDA(At, 0, 1); PG8_STAGE(PG8_SB(0, 0), b2, voffB); PG8_STAGE(PG8_SB(0, 1), b2 + hstep, voffB); PG8_STAGE(PG8_SA(0, 0), a2, voffA);
            PG8_WAIT_V(8); PG8_WAIT_L(0); PG8_BAR; PG8_MMA(1, 0, At, B0); PG8_MMA(1, 1, At, B1); PG8_BAR; PG8_SCHED;
            PG8_LDB(B0, 1, 0); PG8_LDB(B1, 1, 1); PG8_SCHED; PG8_LDA(At, 1, 0); PG8_STAGE(PG8_SA(0, 1), a2 + hstep, voffA);
            PG8_WAIT_V(8); PG8_WAIT_L(0); PG8_BAR; PG8_MMA(0, 0, At, B0); PG8_MMA(0, 1, At, B1); PG8_BAR; PG8_SCHED;
            PG8_LDA(At, 1, 1); PG8_STAGE(PG8_SB(1, 0), b3, voffB); PG8_STAGE(PG8_SB(1, 1), b3 + hstep, voffB); PG8_STAGE(PG8_SA(1, 0), a3, voffA);
            PG8_WAIT_V(8); PG8_WAIT_L(0); PG8_BAR; PG8_MMA(1, 0, At, B0); PG8_MMA(1, 1, At, B1); PG8_BAR; PG8_SCHED;
            } else {
            PG8_LDB(B0, 0, 0); PG8_SCHED; PG8_LDA(At, 0, 0); PG8_STAGE(PG8_SA(1, 1), a1 + hstep, voffA);
            PG8_WAIT_L(8); PG8_BAR; PG8_WAIT_L(0); PG8_MMA(0, 0, At, B0); PG8_BAR; PG8_SCHED;
            PG8_LDB(B1, 0, 1); PG8_STAGE(PG8_SB(0, 0), b2, voffB);
            PG8_BAR; PG8_WAIT_L(0); PG8_MMA(0, 1, At, B1); PG8_BAR;
            PG8_LDA(At, 0, 1); PG8_STAGE(PG8_SA(0, 0), a2, voffA);
            PG8_BAR; PG8_WAIT_L(0); PG8_MMA(1, 0, At, B0); PG8_BAR; PG8_SCHED;
            PG8_STAGE(PG8_SB(0, 1), b2 + hstep, voffB);
            PG8_WAIT_V(6); PG8_BAR; PG8_MMA(1, 1, At, B1); PG8_BAR;
            PG8_LDB(B0, 1, 0); PG8_SCHED; PG8_LDA(At, 1, 0); PG8_STAGE(PG8_SA(0, 1), a2 + hstep, voffA);
            PG8_WAIT_L(8); PG8_BAR; PG8_WAIT_L(0); PG8_MMA(0, 0, At, B0); PG8_BAR; PG8_SCHED;
            PG8_LDB(B1, 1, 1); PG8_STAGE(PG8_SB(1, 0), b3, voffB);
            PG8_BAR; PG8_WAIT_L(0); PG8_MMA(0, 1, At, B1); PG8_BAR;
            PG8_LDA(At, 1, 1); PG8_STAGE(PG8_SA(1, 0), a3, voffA);
            PG8_BAR; PG8_WAIT_L(0); PG8_MMA(1, 0, At, B0); PG8_BAR; PG8_SCHED;
            PG8_STAGE(PG8_SB(1, 1), b3 + hstep, voffB);
            PG8_WAIT_V(6); PG8_BAR; PG8_MMA(1, 1, At, B1); PG8_BAR;
            }
        }
        if constexpr (ALIGN_EPI) { if (wr == 0) PG8_BAR; }
        if constexpr (!Epi::AFTER_DRAIN) { E(acc, cur, wr, wc, fr, fq); S.done(cur); }
        if (!has_next) break;
#pragma unroll
        for (int a = 0; a < 2; ++a)
#pragma unroll
            for (int b = 0; b < 2; ++b)
#pragma unroll
                for (int m = 0; m < 4; ++m)
#pragma unroll
                    for (int n = 0; n < 2; ++n) acc[a][b][m][n] = (f32x4){0.f, 0.f, 0.f, 0.f};
        cur = nxt; cA = nA; cB = nB; ++ui;
        if constexpr (ALIGN_EPI) { if (wr == 1) PG8_BAR; }
    }
    PG8_WAIT_V(0);
    if constexpr (!ALIGN_EPI) { if (wr == 0) PG8_BAR; }
    PG8_BAR;
    if constexpr (Epi::AFTER_DRAIN) { E.fused(acc, cur, wr, wc, fr, fq, lds, wid, lane); S.done(cur); }
#undef PG8_SA
#undef PG8_SB
#undef PG8_STAGE
#undef PG8_LDA
#undef PG8_LDB
#undef PG8_MMA
#undef PG8_WAIT_V
#undef PG8_WAIT_L
#undef PG8_BAR
#undef PG8_SCHED
}
}
#define LAS __attribute__((address_space(3)))
#define DI __device__ __forceinline__
typedef unsigned short bf16_t;
typedef float f32x4 __attribute__((ext_vector_type(4)));
typedef unsigned u32x4 __attribute__((ext_vector_type(4)));
typedef unsigned u32x2 __attribute__((ext_vector_type(2)));
constexpr int DM = 1024, SEQ = 16384, CTX = 256, MT = SEQ + CTX, FF = 2816;
constexpr int ABP = 3072, CDP = 4096, ABIN = 1824;
constexpr float EPS = 1e-6f, LOG2E = 1.4426950408889634f;
constexpr size_t MiB = 1u << 20;
constexpr size_t WS_MODX = 0, WS_MODC = 128 * 1024, CTL_ZERO_BYTES = 256 * 1024;
constexpr size_t WS_XC = 1 * MiB, WS_WINAB = 2 * MiB, WS_WOUTAB = 8 * MiB, WS_WINCD = 10 * MiB, WS_WOUTCD = 18 * MiB, WS_H = 20 * MiB;
constexpr size_t WS_FFN0 = 53 * MiB, FFN_SLOT = 16 * MiB + MiB / 2, FFN_W2OFF = 11 * MiB;
constexpr size_t WS_R = 86 * MiB, WS_U = WS_R, WS_PROJAB = WS_R, WS_VAT = 184 * MiB, WS_VBT = 189 * MiB;
constexpr size_t WS_PART = 206 * MiB;
constexpr size_t WS_HG = 53 * MiB, WS_HGD = 118 * MiB, WS_PROJCD = 120 * MiB, WS_VDT = 250 * MiB, WS_END = 267 * MiB;
constexpr size_t WS_DUMMY = 268 * MiB;
constexpr size_t WS_BAR = 80 * 1024;
constexpr int LDS_BYTES = 132 * 1024, LDS_BARST = LDS_BYTES - 16;
#ifdef DUP_PH
constexpr int NPH = 25;
#else
constexpr int NPH = 24;
#endif

struct Params { const float* in[25]; float* out; unsigned char* ws; int ph_lo, ph_hi; };

DI float bf2f(bf16_t v) { return __uint_as_float(((unsigned)v) << 16); }
DI bf16_t f2bf(float f) { unsigned u = __float_as_uint(f); return (bf16_t)((u + 0x7fffu + ((u >> 16) & 1u)) >> 16); }
DI unsigned pk2(float lo, float hi) { return (unsigned)f2bf(lo) | ((unsigned)f2bf(hi) << 16); }
#define SHX(v, o) __builtin_bit_cast(float, __builtin_amdgcn_ds_bpermute(((lane) ^ (o)) << 2, __builtin_bit_cast(int, (float)(v))))
#define DPP_ADD(v, ctrl) ((v) + __builtin_bit_cast(float, __builtin_amdgcn_update_dpp(0, __builtin_bit_cast(int, (float)(v)), (ctrl), 0xf, 0xf, false)))
DI float wave_sum(float v, int lane) {
    (void)lane;
    v = DPP_ADD(v, 0xB1); v = DPP_ADD(v, 0x4E); v = DPP_ADD(v, 0x141); v = DPP_ADD(v, 0x140);
    const int iv = __builtin_bit_cast(int, v);
    const float a = __builtin_bit_cast(float, __builtin_amdgcn_readlane(iv, 0)), b = __builtin_bit_cast(float, __builtin_amdgcn_readlane(iv, 16));
    const float c = __builtin_bit_cast(float, __builtin_amdgcn_readlane(iv, 32)), d = __builtin_bit_cast(float, __builtin_amdgcn_readlane(iv, 48));
    return (a + b) + (c + d);
}
DI float silu(float x) { return x / (1.0f + __expf(-x)); }
DI float sigmoidf_(float x) { return 1.0f / (1.0f + __expf(-x)); }
DI int swap23(int p) { return (p & ~12) | ((p & 8) >> 1) | ((p & 4) << 1); }
#define LDS_WAIT() asm volatile("s_waitcnt lgkmcnt(0)" ::: "memory")

struct SrcPlain { const float* W; int N; DI float operator()(int k, int n) const { return W[(size_t)k * N + n]; } };
struct SrcW13 { const float* w1; long d31; DI float operator()(int k, int n) const { return w1[(long)k * FF + ((n >> 8) << 7) + (n & 127) + ((n & 128) ? d31 : 0l)]; } };
template <class Src> DI void transpose_item(const Src& src, int K, bf16_t* WT, LAS float* scr, int kb, int nb, int lane) {
    const int k0 = 64 * kb, n0 = 32 * nb;
    float tv[32];
#pragma unroll
    for (int i = 0; i < 32; ++i) tv[i] = src(k0 + 2 * i + (lane >> 5), n0 + (lane & 31));
    __builtin_amdgcn_sched_barrier(0);
#pragma unroll
    for (int i = 0; i < 32; ++i) scr[(2 * i + (lane >> 5)) * 33 + (lane & 31)] = tv[i];
    LDS_WAIT();
    const int c = lane & 7;
#pragma unroll
    for (int j = 0; j < 4; ++j) { const int n = (lane >> 3) + 8 * j; const LAS float* s = scr + (8 * c) * 33 + n;
        u32x4 o; o.x = pk2(s[0 * 33], s[1 * 33]); o.y = pk2(s[2 * 33], s[3 * 33]); o.z = pk2(s[4 * 33], s[5 * 33]); o.w = pk2(s[6 * 33], s[7 * 33]);
        *(u32x4*)(WT + (size_t)(n0 + n) * K + k0 + 8 * c) = o; }
    LDS_WAIT();
}
constexpr int FFN_ITEMS = 16 * 176 + 44 * 32;
DI void convert_ffn_item(const Params& P, int l, int j, int slot, int it, LAS float* scr, int lane) {
    const size_t wo = (size_t)(l * 2 + j) * DM * FF;
    bf16_t* W13t = (bf16_t*)(P.ws + WS_FFN0 + slot * FFN_SLOT); bf16_t* W2t = (bf16_t*)(P.ws + WS_FFN0 + slot * FFN_SLOT + FFN_W2OFF);
    if (it < 16 * 176) { SrcW13 s{P.in[7] + wo, (long)(P.in[8] - P.in[7])}; transpose_item(s, DM, W13t, scr, it / 176, it % 176, lane); }
    else { it -= 16 * 176; SrcPlain s{P.in[9] + wo, DM}; transpose_item(s, FF, W2t, scr, it / 32, it % 32, lane); }
}
DI void phase_prologue(const Params& P, LAS unsigned char* lds, int tid, int wave, int lane, bool second) {
    LAS float* scr = (LAS float*)(lds + wave * 16384);
    const int gw = blockIdx.x * 8 + wave, ngw = gridDim.x * 8;
    constexpr int I_AB = 16 * 57, I_O = 16 * 32, I_CD = 16 * 128;
    constexpr int NIT = 2 * FFN_ITEMS + I_AB + I_O + I_CD + I_O;
    for (int it = gw; it < NIT; it += ngw) {
        int r = it;
        if (r < FFN_ITEMS) { convert_ffn_item(P, 0, 0, 0, r, scr, lane); continue; } r -= FFN_ITEMS;
        if (r < FFN_ITEMS) { convert_ffn_item(P, 0, 1, 1, r, scr, lane); continue; } r -= FFN_ITEMS;
        if (r < I_AB) { SrcPlain s{P.in[10], ABIN}; transpose_item(s, DM, (bf16_t*)(P.ws + WS_WINAB), scr, r / 57, r % 57, lane); continue; } r -= I_AB;
        if (r < I_O) { SrcPlain s{P.in[17], DM}; transpose_item(s, DM, (bf16_t*)(P.ws + WS_WOUTAB), scr, r / 32, r % 32, lane); continue; } r -= I_O;
        if (r < I_CD) { SrcPlain s{P.in[18], CDP}; transpose_item(s, DM, (bf16_t*)(P.ws + WS_WINCD), scr, r / 128, r % 128, lane); continue; } r -= I_CD;
        { SrcPlain s{P.in[24], DM}; transpose_item(s, DM, (bf16_t*)(P.ws + WS_WOUTCD), scr, r / 32, r % 32, lane); }
    }
    __syncthreads();
    {
        LAS float* As = (LAS float*)lds; LAS float* Bs = (LAS float*)(lds + 64 * 33 * 4);
        const float* Win = P.in[10]; const float* gk = P.in[15]; const float* wu = P.in[16];
        bf16_t* Wt = (bf16_t*)(P.ws + WS_WINAB);
        for (int t = blockIdx.x; t < 256; t += gridDim.x) {
            const int n0 = (t >> 4) * 64, k0 = (t & 15) * 64, kl = tid & 63, ng = tid >> 6;
            float acc[8];
#pragma unroll
            for (int i = 0; i < 8; ++i) acc[i] = 0.f;
            const int kk = tid >> 3, jj4 = (tid & 7) * 4, jb = tid >> 4, nn4 = (tid & 15) * 4;
            f32x4 av = *(const f32x4*)(Win + (size_t)(k0 + kk) * ABIN + 1536 + jj4), bv = *(const f32x4*)(wu + (size_t)jb * DM + n0 + nn4); float gv = gk[jb];
            for (int jc = 0; jc < 8; ++jc) {
                As[kk * 33 + jj4] = av.x; As[kk * 33 + jj4 + 1] = av.y; As[kk * 33 + jj4 + 2] = av.z; As[kk * 33 + jj4 + 3] = av.w;
                Bs[jb * 64 + nn4] = gv * bv.x; Bs[jb * 64 + nn4 + 1] = gv * bv.y; Bs[jb * 64 + nn4 + 2] = gv * bv.z; Bs[jb * 64 + nn4 + 3] = gv * bv.w;
                __syncthreads();
                if (jc < 7) { const int j1 = (jc + 1) * 32;
                    av = *(const f32x4*)(Win + (size_t)(k0 + kk) * ABIN + 1536 + j1 + jj4); bv = *(const f32x4*)(wu + (size_t)(j1 + jb) * DM + n0 + nn4); gv = gk[j1 + jb]; }
#pragma unroll 8
                for (int jj = 0; jj < 32; ++jj) { const float a = As[kl * 33 + jj];
#pragma unroll
                    for (int i = 0; i < 8; ++i) acc[i] += a * Bs[jj * 64 + ng * 8 + i]; }
                __syncthreads();
            }
#pragma unroll
            for (int i = 0; i < 8; ++i) Wt[(size_t)(ABIN + n0 + ng * 8 + i) * DM + k0 + kl] = f2bf(acc[i]);
        }
        { u32x4* z = (u32x4*)(Wt + (size_t)2848 * DM); const int nz = 224 * DM * 2 / 16;
          unsigned zz_ = 0u; asm volatile("" : "+v"(zz_));
          for (int i = blockIdx.x * 512 + tid; i < nz; i += gridDim.x * 512) z[i] = (u32x4){zz_, zz_, zz_, zz_}; }
    }
    { const f32x4* src = (const f32x4*)P.in[2]; f32x4* dst = (f32x4*)(P.ws + WS_XC); for (int i = blockIdx.x * 512 + tid; i < CTX * DM / 4; i += gridDim.x * 512) dst[i] = src[i]; }
    {
        float* modx = (float*)(P.ws + (second ? WS_DUMMY : WS_MODX)); float* modc = (float*)(P.ws + (second ? WS_DUMMY + 128 * 1024 : WS_MODC));
        const float* cv = P.in[1]; const float* cc = P.in[3];
        for (int it = blockIdx.x; it < 2 * 18 * 8; it += gridDim.x) {
            const int l = it / (18 * 8), r = it % (18 * 8), cb = r / 8, kc = r % 8, n = cb * 512 + tid;
            float ax = 0.f, ac = 0.f;
            for (int kb = kc * 128; kb < kc * 128 + 128; kb += 32) {
                const float* w = P.in[5] + (size_t)l * DM * 9216 + (size_t)kb * 9216 + n;
                float wv[32];
#pragma unroll
                for (int kk = 0; kk < 32; ++kk) wv[kk] = w[(size_t)kk * 9216];
                __builtin_amdgcn_sched_barrier(0);
#pragma unroll
                for (int kk = 0; kk < 32; ++kk) { ax += silu(cv[kb + kk]) * wv[kk]; ac += silu(cc[kb + kk]) * wv[kk]; }
            }
            if (kc == 0) { const float b = P.in[6][l * 9216 + n]; ax += b; ac += b; }
            atomicAdd(modx + l * 9216 + n, ax); atomicAdd(modc + l * 9216 + n, ac);
        }
    }
}

DI void phase_normmod(const Params& P, int l, int idx, bool first, int nrows, int nsplit, int wave, int lane) {
    const float* g = P.in[4] + (l * 3 + idx) * DM;
    const float* modx = (const float*)(P.ws + WS_MODX) + l * 9216; const float* modc = (const float*)(P.ws + WS_MODC) + l * 9216;
    bf16_t* H = (bf16_t*)(P.ws + WS_H);
    const int gw = blockIdx.x * 8 + wave, ngw = gridDim.x * 8;
    for (int m = gw; m < nrows; m += ngw) {
        const bool isC = m >= SEQ;
        const float* src = isC ? ((first ? P.in[2] : (const float*)(P.ws + WS_XC)) + (size_t)(m - SEQ) * DM) : ((first ? P.in[0] : (const float*)P.out) + (size_t)m * DM);
        const float* mod = isC ? modc : modx; const float* shift = mod + (idx * 3) * DM; const float* scale = mod + (idx * 3 + 1) * DM;
        f32x4 v[4]; float ss = 0.f;
#pragma unroll
        for (int j = 0; j < 4; ++j) { v[j] = ((const f32x4*)src)[64 * j + lane]; ss += (v[j].x * v[j].x + v[j].y * v[j].y) + (v[j].z * v[j].z + v[j].w * v[j].w); }
        if (isC && nsplit > 0) {
            const float* part = (const float*)(P.ws + WS_PART) + (size_t)(m - SEQ) * DM; float* xc = (float*)(P.ws + WS_XC) + (size_t)(m - SEQ) * DM;
            for (int sp = 0; sp < nsplit; ++sp) {
#pragma unroll
                for (int j = 0; j < 4; ++j) v[j] += ((const f32x4*)(part + (size_t)sp * CTX * DM))[64 * j + lane]; }
            ss = 0.f;
#pragma unroll
            for (int j = 0; j < 4; ++j) { ((f32x4*)xc)[64 * j + lane] = v[j]; ss += (v[j].x * v[j].x + v[j].y * v[j].y) + (v[j].z * v[j].z + v[j].w * v[j].w); }
        }
        ss = wave_sum(ss, lane); const float rstd = rsqrtf(ss * (1.0f / DM) + EPS);
#pragma unroll
        for (int j = 0; j < 4; ++j) { const int col = 4 * (64 * j + lane);
            const f32x4 gv = *(const f32x4*)(g + col), sc = *(const f32x4*)(scale + col), sh = *(const f32x4*)(shift + col);
            const f32x4 y = (v[j] * rstd * gv) * (sc + 1.0f) + sh;
            u32x2 w; w.x = pk2(y.x, y.y); w.y = pk2(y.z, y.w); *(u32x2*)(H + (size_t)m * DM + col) = w; }
    }
}

DI void phase_postAB(const Params& P, LAS unsigned char* lds, int tid, int wave, int lane, bool second) {
    bf16_t* proj = (bf16_t*)(P.ws + WS_PROJAB); bf16_t* VAT = (bf16_t*)(P.ws + WS_VAT); bf16_t* VBT = (bf16_t*)(P.ws + WS_VBT);
    LAS bf16_t* vt = (LAS bf16_t*)lds; constexpr int VTS = 18;
    const float aqn = P.in[11][lane], akn = P.in[12][lane], bqn0 = P.in[13][lane], bqn1 = P.in[13][64 + (lane & 31)], bkn0 = P.in[14][lane], bkn1 = P.in[14][64 + (lane & 31)];
    const float invA = exp2f(-(float)(lane & 15) * (13.287712379549449f / 16.0f)), invB = exp2f(-(float)(lane & 7) * (13.287712379549449f / 8.0f));
    const float sgnA = (lane & 16) ? 1.f : -1.f, sgnB = (lane & 8) ? 1.f : -1.f;
    const float qsA = 0.125f * LOG2E, qsB = 0.10206207261596577f * LOG2E;
    const bool lo = lane < 32;
    for (int tile = blockIdx.x; tile < MT / 16; tile += gridDim.x) {
        for (int i = 0; i < 2; ++i) {
            const int tt = wave * 2 + i, m = tile * 16 + tt, pp = swap23(tt); const bool rot = m < SEQ;
            bf16_t* raw = proj + (size_t)m * ABP;
            const bf16_t* rawi = raw; if (second) raw = (bf16_t*)(P.ws + WS_DUMMY) + (size_t)(m & 1023) * ABP;
            bf16_t rq[8], rk[2], rbq0[8], rbq1[8], rl[4], rkn[8], rvv[8], xv[2], rkr;
#pragma unroll
            for (int hh = 0; hh < 8; ++hh) { rq[hh] = rawi[hh * 64 + lane]; rbq0[hh] = rawi[768 + hh * 96 + lane]; rbq1[hh] = rawi[768 + hh * 96 + 64 + (lane & 31)];
                rkn[hh] = rawi[ABIN + hh * 128 + lane]; rvv[hh] = rawi[ABIN + hh * 128 + 64 + lane]; }
#pragma unroll
            for (int hh = 0; hh < 2; ++hh) { rk[hh] = rawi[512 + hh * 64 + lane]; xv[hh] = rawi[640 + hh * 64 + lane]; }
#pragma unroll
            for (int j = 0; j < 4; ++j) rl[j] = rawi[1536 + 64 * j + lane];
            rkr = rawi[1792 + (lane & 31)];
            __builtin_amdgcn_sched_barrier(0);
            float xq[8], xk[2], xbq0[8], xbq1[8], xl[4], xkn[8], xvv[8];
#pragma unroll
            for (int hh = 0; hh < 8; ++hh) { xq[hh] = bf2f(rq[hh]); xbq0[hh] = bf2f(rbq0[hh]); xbq1[hh] = lo ? bf2f(rbq1[hh]) : 0.f; xkn[hh] = bf2f(rkn[hh]); xvv[hh] = bf2f(rvv[hh]); }
#pragma unroll
            for (int hh = 0; hh < 2; ++hh) xk[hh] = bf2f(rk[hh]);
#pragma unroll
            for (int j = 0; j < 4; ++j) xl[j] = bf2f(rl[j]);
            const float kr = lo ? bf2f(rkr) : 0.f;
            const float pr = (float)(m >> 6), pc = (float)(m & 63);
            float cA = 1.f, sA = 0.f, cB = 1.f, sB = 0.f;
            if (rot) { const float angA = ((lane & 32) ? pc : pr) * invA, angB = ((lane & 16) ? pc : pr) * invB; cA = cosf(angA); sA = sinf(angA); cB = cosf(angB); sB = sinf(angB); }
#pragma unroll
            for (int hh = 0; hh < 8; ++hh) { const float x = xq[hh]; const float ss = wave_sum(x * x, lane);
                float y = x * rsqrtf(ss * (1.f / 64.f) + EPS) * aqn; const float pt = SHX(y, 16); y = y * cA + sgnA * pt * sA; raw[hh * 64 + lane] = f2bf(y * qsA); }
#pragma unroll
            for (int hh = 0; hh < 2; ++hh) { const float x = xk[hh]; const float ss = wave_sum(x * x, lane);
                float y = x * rsqrtf(ss * (1.f / 64.f) + EPS) * akn; const float pt = SHX(y, 16); y = y * cA + sgnA * pt * sA; raw[512 + hh * 64 + lane] = f2bf(y);
                vt[(hh * 64 + lane) * VTS + pp] = xv[hh]; }
#pragma unroll
            for (int hh = 0; hh < 8; ++hh) { const float x0 = xbq0[hh], x1 = xbq1[hh];
                const float ss = wave_sum(x0 * x0 + x1 * x1, lane); const float rs = rsqrtf(ss * (1.f / 96.f) + EPS);
                const float y0 = x0 * rs * bqn0; float y1 = x1 * rs * bqn1; const float pt = SHX(y1, 8); y1 = y1 * cB + sgnB * pt * sB;
                raw[768 + hh * 96 + lane] = f2bf(y0 * qsB); if (lo) raw[768 + hh * 96 + 64 + lane] = f2bf(y1 * qsB); }
            const float rkv = rsqrtf(wave_sum(xl[0] * xl[0] + xl[1] * xl[1] + xl[2] * xl[2] + xl[3] * xl[3], lane) * (1.f / 256.f) + EPS);
#pragma unroll
            for (int hh = 0; hh < 8; ++hh) { const float kn = xkn[hh] * rkv; const float vv = xvv[hh] * rkv;
                const float ss = wave_sum(kn * kn + kr * kr, lane); const float rs = rsqrtf(ss * (1.f / 96.f) + EPS);
                const float y0 = kn * rs * bkn0; float y1 = kr * rs * bkn1; const float pt = SHX(y1, 8); y1 = y1 * cB + sgnB * pt * sB;
                raw[ABIN + hh * 128 + lane] = f2bf(y0); if (lo) raw[ABIN + hh * 128 + 64 + lane] = f2bf(y1);
                vt[(128 + hh * 64 + lane) * VTS + pp] = f2bf(vv); }
        }
        __syncthreads();
        for (int c = tid; c < 640 * 2; c += 512) { const int row = c >> 1, c8 = c & 1; const LAS unsigned* s = (const LAS unsigned*)(vt + row * VTS + 8 * c8);
            u32x4 o; o.x = s[0]; o.y = s[1]; o.z = s[2]; o.w = s[3];
            bf16_t* dst = row < 128 ? VAT + (size_t)row * MT : VBT + (size_t)(row - 128) * MT;
            if (second) dst = (bf16_t*)(P.ws + WS_DUMMY + 8 * MiB) + (size_t)row * 1024 - tile * 16 + (tile & 31) * 16;
            *(u32x4*)(dst + tile * 16 + 8 * c8) = o; }
        __syncthreads();
    }
}

typedef short bf16x8 __attribute__((ext_vector_type(8)));
typedef float f32x16 __attribute__((ext_vector_type(16)));
typedef float f32x2_t __attribute__((ext_vector_type(2)));
typedef __bf16 bf16x2_t __attribute__((ext_vector_type(2)));
DI unsigned cvtpk(float lo, float hi) { f32x2_t v = {lo, hi}; bf16x2_t b = __builtin_convertvector(v, bf16x2_t); return __builtin_bit_cast(unsigned, b); }
DI bf16x8 pack8(const f32x16& p, int s8) { u32x4 w; w.x = cvtpk(p[s8 + 0], p[s8 + 1]); w.y = cvtpk(p[s8 + 2], p[s8 + 3]); w.z = cvtpk(p[s8 + 4], p[s8 + 5]); w.w = cvtpk(p[s8 + 6], p[s8 + 7]); return __builtin_bit_cast(bf16x8, w); }
#define MFMA32(a, b, c) __builtin_amdgcn_mfma_f32_32x32x16_bf16((a), (b), (c), 0, 0, 0)
template <int DQK, bool NA, int EXPV = 0> DI void attn_unit(const bf16_t* proj, int pitch, int qcol, int kcol, const bf16_t* VT, bf16_t* H, int ocol, int q0, int t_lo, int t_hi, LAS unsigned char* lds, int tid, int wave, int lane,
                                             const float* rpb = nullptr, int nwin = 0, int krow0 = 0) {
    constexpr int KS = DQK * 2 + 16, KBUF = 64 * KS, VS = 144, VBUF = 64 * VS, CPR = DQK / 8, NDS = DQK / 16;
    LAS unsigned char* Kb = lds; LAS unsigned char* Vb = lds + 2 * KBUF;
    const int r32 = lane & 31, h = lane >> 5;
    const int k0r = tid / CPR, k0c = tid % CPR, k1r = (512 + tid) / CPR, k1c = (512 + tid) % CPR, vrow = tid >> 3, vc = tid & 7;
    const bool two = (DQK == 96) && tid < 256;
    bf16x8 qf[NDS];
    { const bf16_t* qp = proj + (size_t)(q0 + wave * 32 + r32) * pitch + qcol + 8 * h;
#pragma unroll
      for (int ds = 0; ds < NDS; ++ds) qf[ds] = *(const bf16x8*)(qp + 16 * ds); }
    f32x16 o0, o1, negm;
#pragma unroll
    for (int r = 0; r < 16; ++r) { o0[r] = 0.f; o1[r] = 0.f; negm[r] = 0.f; }
    float mhat = 0.f, l = 0.f;
    unsigned zz_ = 0u; asm volatile("" : "+v"(zz_)); u32x4 kr0, kr1 = (u32x4){zz_, zz_, zz_, zz_}, vr;
    LAS float* rpbs = (LAS float*)(lds + 2 * KBUF + 2 * VBUF);
    int na_r = 0, na_c = 0, na_rs = 0, na_cs = 0;
    if (NA) { if (tid < 465) rpbs[tid] = rpb[tid] * LOG2E; na_r = (q0 >> 6) + (wave >> 1); na_c = 32 * (wave & 1) + r32; na_rs = min(max(na_r - 4, 0), 248); na_cs = min(max(na_c - 8, 0), 48); }
#define AT_KV0(t) (NA ? ((t) < nwin ? (krow0 + (t)) * 64 : SEQ + ((t) - nwin) * 64) : (t) * 64)
#define AT_GLOAD(t) do { const int kv0_ = AT_KV0(t); kr0 = *(const u32x4*)(proj + (size_t)(kv0_ + k0r) * pitch + kcol + 8 * k0c); \
        if (two) kr1 = *(const u32x4*)(proj + (size_t)(kv0_ + k1r) * pitch + kcol + 8 * k1c); vr = *(const u32x4*)(VT + (size_t)vrow * MT + kv0_ + 8 * vc); } while (0)
#define AT_LSTORE(b) do { *(LAS u32x4*)(Kb + (b) * KBUF + k0r * KS + 16 * k0c) = kr0; if (two) *(LAS u32x4*)(Kb + (b) * KBUF + k1r * KS + 16 * k1c) = kr1; \
        *(LAS u32x4*)(Vb + (b) * VBUF + vrow * VS + 16 * vc) = vr; } while (0)
    AT_GLOAD(t_lo); AT_LSTORE(0); __syncthreads();
    if (t_lo + 1 < t_hi) AT_GLOAD(t_lo + 1);
    for (int t = t_lo; t < t_hi; ++t) {
        const int b = (t - t_lo) & 1;
        if (EXPV != 1 && t + 1 < t_hi) AT_LSTORE(b ^ 1);
        if (EXPV != 1 && t + 2 < t_hi) AT_GLOAD(t + 2);
        const int na_kr = krow0 + t;
        const bool active = !NA || t >= nwin || (na_kr >= na_rs && na_kr < na_rs + 8);
        if (active) {
        f32x16 p0, p1;
        bf16x8 vf0[4], vf1[4];
        { bf16x8 kf0[NDS], kf1[NDS];
          const LAS unsigned char* kb = Kb + b * KBUF + r32 * KS + 16 * h; const LAS unsigned char* vb = Vb + b * VBUF + r32 * VS + 16 * h;
#pragma unroll
          for (int ds = 0; ds < NDS; ++ds) { kf0[ds] = *(const LAS bf16x8*)(kb + 32 * ds); kf1[ds] = *(const LAS bf16x8*)(kb + 32 * KS + 32 * ds); }
          __builtin_amdgcn_sched_barrier(0);
#pragma unroll
          for (int ds = 0; ds < NDS; ++ds) {
              if (ds == 0) { p0 = MFMA32(kf0[0], qf[0], negm); p1 = MFMA32(kf1[0], qf[0], negm); } else { p0 = MFMA32(kf0[ds], qf[ds], p0); p1 = MFMA32(kf1[ds], qf[ds], p1); }
              if (ds < 4) { vf0[ds] = *(const LAS bf16x8*)(vb + 32 * ds); vf1[ds] = *(const LAS bf16x8*)(vb + 32 * VS + 32 * ds); }
              __builtin_amdgcn_sched_barrier(0); } }
        if (NA && t < nwin) { const LAS float* bp = rpbs + (na_kr - na_r + 7) * 31 + 15 - na_c;
#pragma unroll
            for (int r = 0; r < 16; ++r) { const int kc = (r & 3) + 8 * (r >> 2) + 4 * h;
                { const bool ok = kc >= na_cs && kc < na_cs + 16; p0[r] = ok ? p0[r] + bp[ok ? kc : na_c] : -1e30f; }
                { const int kc1 = kc + 32; const bool ok = kc1 >= na_cs && kc1 < na_cs + 16; p1[r] = ok ? p1[r] + bp[ok ? kc1 : na_c] : -1e30f; } } }
        float mt = 0.f;
        if (EXPV != 2) { mt = __builtin_fmaxf(__builtin_fmaxf(p0[0], p1[0]), p0[1]);
#pragma unroll
        for (int r = 1; r < 16; r += 1) mt = __builtin_fmaxf(__builtin_fmaxf(mt, p1[r]), r + 1 < 16 ? p0[r + 1] : p1[r]);
        mt = fmaxf(mt, SHX(mt, 32)); }
        if (EXPV != 2 && __any(mt > 8.0f)) {
            const float dlt = fmaxf(mt, 0.f), alpha = __builtin_amdgcn_exp2f(-dlt); mhat += dlt;
#pragma unroll
            for (int r = 0; r < 16; ++r) { p0[r] -= dlt; p1[r] -= dlt; negm[r] = -mhat; }
            l *= alpha; o0 = o0 * alpha; o1 = o1 * alpha;
        }
        float la = 0.f;
#pragma unroll
        for (int r = 0; r < 16; ++r) { if (EXPV != 2) { p0[r] = __builtin_amdgcn_exp2f(p0[r]); p1[r] = __builtin_amdgcn_exp2f(p1[r]); la += p0[r]; la += p1[r]; } }
        l += la;
        bf16x8 pb[4]; pb[0] = pack8(p0, 0); pb[1] = pack8(p0, 8); pb[2] = pack8(p1, 0); pb[3] = pack8(p1, 8);
#pragma unroll
        for (int ks = 0; ks < 4; ++ks) { o0 = MFMA32(vf0[ks], pb[ks], o0); o1 = MFMA32(vf1[ks], pb[ks], o1); }
        }
        __syncthreads();
    }
#undef AT_GLOAD
#undef AT_KV0
#undef AT_LSTORE
    l += SHX(l, 32); const float il = 1.0f / l;
    bf16_t* op = H + (size_t)(q0 + wave * 32 + r32) * DM + ocol + 4 * h;
#pragma unroll
    for (int g = 0; g < 4; ++g) {
        u32x2 w0; w0.x = cvtpk(o0[4 * g] * il, o0[4 * g + 1] * il); w0.y = cvtpk(o0[4 * g + 2] * il, o0[4 * g + 3] * il); *(u32x2*)(op + 8 * g) = w0;
        u32x2 w1; w1.x = cvtpk(o1[4 * g] * il, o1[4 * g + 1] * il); w1.y = cvtpk(o1[4 * g + 2] * il, o1[4 * g + 3] * il); *(u32x2*)(op + 32 + 8 * g) = w1; }
}
DI void phase_attn(const Params& P, LAS unsigned char* lds, int tid, int wave, int lane, bool second) {
    const bf16_t* proj = (const bf16_t*)(P.ws + WS_PROJAB); const bf16_t* VAT = (const bf16_t*)(P.ws + WS_VAT); const bf16_t* VBT = (const bf16_t*)(P.ws + WS_VBT);
    bf16_t* H = (bf16_t*)(P.ws + WS_H);
    for (int u = blockIdx.x; u < 1040; u += gridDim.x) {
        int hd, q0, t_lo;
        if (u < 1024) { const int i = u >> 8, r = u & 255, x = r & 7, j = r >> 3; hd = (i >> 1) * 8 + x; q0 = (j + 32 * (i & 1)) * 256; t_lo = 0; }
        else { hd = u - 1024; q0 = SEQ; t_lo = SEQ / 64; }
#ifdef ATTN_EXPV
        if (second) { bf16_t* Hd = (bf16_t*)(P.ws + WS_DUMMY);
            if (hd < 8) attn_unit<64, false, ATTN_EXPV>(proj, ABP, hd * 64, 512 + (hd >> 2) * 64, VAT + (size_t)(hd >> 2) * 64 * MT, Hd, hd * 64, q0 & 8191, t_lo, MT / 64, lds, tid, wave, lane);
            else { const int hb = hd - 8; attn_unit<96, false, ATTN_EXPV>(proj, ABP, 768 + hb * 96, ABIN + hb * 128, VBT + (size_t)hb * 64 * MT, Hd, 512 + hb * 64, q0 & 8191, t_lo, MT / 64, lds, tid, wave, lane); }
            continue; }
#endif
        if (hd < 8) attn_unit<64, false>(proj, ABP, hd * 64, 512 + (hd >> 2) * 64, VAT + (size_t)(hd >> 2) * 64 * MT, H, hd * 64, q0, t_lo, MT / 64, lds, tid, wave, lane);
        else { const int hb = hd - 8; attn_unit<96, false>(proj, ABP, 768 + hb * 96, ABIN + hb * 128, VBT + (size_t)hb * 64 * MT, H, 512 + hb * 64, q0, t_lo, MT / 64, lds, tid, wave, lane); }
    }
}

DI void phase_postCD(const Params& P, LAS unsigned char* lds, int tid, int wave, int lane, bool second) {
    bf16_t* proj = (bf16_t*)(P.ws + WS_PROJCD); bf16_t* VDT = (bf16_t*)(P.ws + WS_VDT);
    LAS bf16_t* vt = (LAS bf16_t*)lds; constexpr int VTS = 18;
    const float dqn = P.in[21][lane] * (0.125f * LOG2E), dkn = P.in[22][lane];
    for (int tile = blockIdx.x; tile < MT / 16; tile += gridDim.x) {
        for (int i = 0; i < 2; ++i) {
            const int tt = wave * 2 + i, m = tile * 16 + tt, pp = swap23(tt);
            bf16_t* raw = proj + (size_t)m * CDP; const bf16_t* rawi = raw; if (second) raw = (bf16_t*)(P.ws + WS_DUMMY) + (size_t)(m & 1023) * CDP;
            float xq[8], xk[8]; bf16_t rq[8], rk[8], xv[8];
#pragma unroll
            for (int hh = 0; hh < 8; ++hh) { rq[hh] = rawi[2560 + hh * 64 + lane]; rk[hh] = rawi[3072 + hh * 64 + lane]; xv[hh] = rawi[3584 + hh * 64 + lane]; }
            __builtin_amdgcn_sched_barrier(0);
#pragma unroll
            for (int hh = 0; hh < 8; ++hh) { xq[hh] = bf2f(rq[hh]); xk[hh] = bf2f(rk[hh]); }
#pragma unroll
            for (int hh = 0; hh < 8; ++hh) {
                { const float x = xq[hh]; const float ss = wave_sum(x * x, lane); raw[2560 + hh * 64 + lane] = f2bf(x * rsqrtf(ss * (1.f / 64.f) + EPS) * dqn); }
                { const float x = xk[hh]; const float ss = wave_sum(x * x, lane); raw[3072 + hh * 64 + lane] = f2bf(x * rsqrtf(ss * (1.f / 64.f) + EPS) * dkn); }
                vt[(hh * 64 + lane) * VTS + pp] = xv[hh]; }
        }
        __syncthreads();
        for (int c = tid; c < 512 * 2; c += 512) { const int row = c >> 1, c8 = c & 1; const LAS unsigned* s = (const LAS unsigned*)(vt + row * VTS + 8 * c8);
            u32x4 o; o.x = s[0]; o.y = s[1]; o.z = s[2]; o.w = s[3];
            bf16_t* dst = VDT + (size_t)row * MT + tile * 16; if (second) dst = (bf16_t*)(P.ws + WS_DUMMY + 8 * MiB) + (size_t)row * 1024 + (tile & 31) * 16;
            *(u32x4*)(dst + 8 * c8) = o; }
        __syncthreads();
    }
}
DI void phase_na(const Params& P, LAS unsigned char* lds, int tid, int wave, int lane) {
    const bf16_t* proj = (const bf16_t*)(P.ws + WS_PROJCD); const bf16_t* VDT = (const bf16_t*)(P.ws + WS_VDT); bf16_t* H = (bf16_t*)(P.ws + WS_H);
    for (int u = blockIdx.x; u < 512; u += gridDim.x) {
        const int hh = u & 7, r0 = (u >> 3) * 4;
        const int krow0 = min(max(r0 - 4, 0), 248), klast = min(max(r0 - 1, 0), 248) + 7, nwin = klast - krow0 + 1;
        attn_unit<64, true>(proj, CDP, 2560 + hh * 64, 3072 + hh * 64, VDT + (size_t)hh * 64 * MT, H, 512 + hh * 64, r0 * 64, 0, nwin + CTX / 64, lds, tid, wave, lane, P.in[23] + hh * 465, nwin, krow0);
    }
}
constexpr int HS = 144;
DI int hg_rowbase(int R) { return R < 256 ? R * 64 : SEQ + (R - 256) * 64; }
#define MFMA32(a, b, c) __builtin_amdgcn_mfma_f32_32x32x16_bf16((a), (b), (c), 0, 0, 0)
DI void hgrn_gates(const Params& P, const bf16_t* proj, int rowbase, int hh, int tid, LAS float* segtot, LAS float* gmids, float (&gc)[16], float (&kin)[16], float& gtot, float& gmid) {
    const int dir = tid >> 8, seg = (tid >> 6) & 3, k = tid & 63, ch = hh * 64 + k;
    const float b0 = P.in[19][dir * 512 + ch], b1 = P.in[19][1024 + dir * 512 + ch]; const float lb = 1.0f / (1.0f + __expf(b0 - b1));
    const bf16_t* zp = proj + (size_t)(rowbase + 16 * seg) * CDP + 512 + dir * 512 + ch;
    float g[16]; bf16_t rz[16];
#pragma unroll
    for (int j = 0; j < 16; ++j) rz[j] = zp[(size_t)j * CDP];
    __builtin_amdgcn_sched_barrier(0);
#pragma unroll
    for (int j = 0; j < 16; ++j) { const float z = bf2f(rz[j]); const float f = lb + (1.0f - lb) * sigmoidf_(z); g[j] = __logf(f); kin[j] = 1.0f - f; }
    if (dir == 0) { float a = 0.f;
#pragma unroll
        for (int j = 0; j < 16; ++j) { a += g[j]; gc[j] = a; } }
    else { float a = 0.f;
#pragma unroll
        for (int j = 15; j >= 0; --j) { a += g[j]; gc[j] = a; } }
    segtot[(dir * 4 + seg) * 64 + k] = dir == 0 ? gc[15] : gc[0];
    __syncthreads();
    float off = 0.f; gtot = 0.f;
#pragma unroll
    for (int s2 = 0; s2 < 4; ++s2) { const float v = segtot[(dir * 4 + s2) * 64 + k]; gtot += v; if (dir == 0 ? (s2 < seg) : (s2 > seg)) off += v; }
#pragma unroll
    for (int j = 0; j < 16; ++j) gc[j] += off;
    if (dir == 0 && seg == 1) gmids[k] = gc[15];
    if (dir == 1 && seg == 2) gmids[64 + k] = gc[0];
    __syncthreads();
    gmid = gmids[dir * 64 + k];
}
DI void phase_hgrn1(const Params& P, LAS unsigned char* lds, int tid, int wave, int lane) {
    const bf16_t* proj = (const bf16_t*)(P.ws + WS_PROJCD); float* HG = (float*)(P.ws + WS_HG); float* HGD = (float*)(P.ws + WS_HGD);
    LAS unsigned char* KdT = lds; LAS unsigned char* VTl = lds + 2 * 64 * HS; LAS float* segtot = (LAS float*)(lds + 3 * 64 * HS); LAS float* gmids = segtot + 512;
    const int r32 = lane & 31, h = lane >> 5;
    for (int it = blockIdx.x; it < 260 * 8; it += gridDim.x) {
        const int R = it >> 3, hh = it & 7, rowbase = hg_rowbase(R);
        float gc[16], kin[16], gtot, gmid;
        const u32x4 vw = *(const u32x4*)(proj + (size_t)(rowbase + (tid >> 3)) * CDP + 1536 + hh * 64 + (tid & 7) * 8);
        hgrn_gates(P, proj, rowbase, hh, tid, segtot, gmids, gc, kin, gtot, gmid);
        const int dir = tid >> 8, seg = (tid >> 6) & 3, k = tid & 63;
        { u32x4 w0, w1; float e[16];
#pragma unroll
          for (int j = 0; j < 16; ++j) e[j] = kin[j] * __expf(gtot - gc[j]);
          w0.x = pk2(e[0], e[1]); w0.y = pk2(e[2], e[3]); w0.z = pk2(e[4], e[5]); w0.w = pk2(e[6], e[7]); w1.x = pk2(e[8], e[9]); w1.y = pk2(e[10], e[11]); w1.z = pk2(e[12], e[13]); w1.w = pk2(e[14], e[15]);
          LAS unsigned char* dst = KdT + (dir * 64 + k) * HS + 32 * seg; *(LAS u32x4*)dst = w0; *(LAS u32x4*)(dst + 16) = w1; }
        { const int s = tid >> 3, v8 = (tid & 7) * 8; const u32x4 w = vw;
          const unsigned ww[4] = {w.x, w.y, w.z, w.w};
#pragma unroll
          for (int i = 0; i < 8; ++i) *(LAS bf16_t*)(VTl + (v8 + i) * HS + 2 * s) = (bf16_t)((ww[i >> 1] >> ((i & 1) * 16)) & 0xffffu); }
        const size_t idx = (size_t)(R * 8 + hh) * 2;
        if (seg == 0) HGD[(idx + dir) * 64 + k] = __expf(gtot);
        __syncthreads();
        { const int d = wave >> 2, vb = (wave >> 1) & 1, kb = wave & 1;
          f32x16 acc;
#pragma unroll
          for (int r = 0; r < 16; ++r) acc[r] = 0.f;
          const LAS unsigned char* ap = VTl + (32 * vb + r32) * HS + 16 * h; const LAS unsigned char* bp = KdT + (d * 64 + 32 * kb + r32) * HS + 16 * h;
#pragma unroll
          for (int ss = 0; ss < 4; ++ss) acc = MFMA32(*(const LAS bf16x8*)(ap + 32 * ss), *(const LAS bf16x8*)(bp + 32 * ss), acc);
          float* out = HG + (idx + d) * 4096 + 32 * kb + r32;
#pragma unroll
          for (int r = 0; r < 16; ++r) out[(size_t)(32 * vb + (r & 3) + 8 * (r >> 2) + 4 * h) * 64] = acc[r]; }
        __syncthreads();
    }
}
DI void phase_hgrn2(const Params& P, int tid, bool second) {
    float* HG = (float*)(P.ws + WS_HG); float* HGo = second ? (float*)(P.ws + WS_DUMMY) : HG; const float* HGD = (const float*)(P.ws + WS_HGD);
    for (int e = blockIdx.x * 512 + tid; e < 65536; e += gridDim.x * 512) {
        const int hh = e >> 13, dir = (e >> 12) & 1, vk = e & 4095, k = e & 63;
        float S = 0.f;
        for (int i0 = 0; i0 < 260; i0 += 13) {
            float Lc[13], Dc[13];
#pragma unroll
            for (int j = 0; j < 13; ++j) { const int i = i0 + j; const int R = dir == 0 ? (i < 4 ? 256 + i : i - 4) : 259 - i; const size_t idx = (size_t)(R * 8 + hh) * 2 + dir;
                Lc[j] = HG[idx * 4096 + vk]; Dc[j] = HGD[idx * 64 + k]; }
            __builtin_amdgcn_sched_barrier(0);
#pragma unroll
            for (int j = 0; j < 13; ++j) { const int i = i0 + j; const int R = dir == 0 ? (i < 4 ? 256 + i : i - 4) : 259 - i; const size_t idx = (size_t)(R * 8 + hh) * 2 + dir;
                HGo[(second ? (idx & 255) : idx) * 4096 + vk] = S; S = Dc[j] * S + Lc[j]; }
        }
    }
}
DI void phase_hgrn3(const Params& P, LAS unsigned char* lds, int tid, int wave, int lane) {
    const bf16_t* proj = (const bf16_t*)(P.ws + WS_PROJCD); const float* HG = (const float*)(P.ws + WS_HG); bf16_t* H = (bf16_t*)(P.ws + WS_H);
    constexpr int MB = 64 * HS;
    LAS unsigned char* Qg = lds; LAS unsigned char* Kg = lds + 2 * MB; LAS unsigned char* Sg = lds + 4 * MB; LAS unsigned char* VTl = lds + 6 * MB;
    LAS float* Os = (LAS float*)(lds + 7 * MB); LAS float* segtot = Os + 64 * 65; LAS float* gmids = segtot + 512;
    const int r32 = lane & 31, h = lane >> 5;
    for (int it = blockIdx.x; it < 256 * 8; it += gridDim.x) {
        const int R = it >> 3, hh = it & 7, rowbase = R * 64;
        float gc[16], kin[16], gtot, gmid;
        bf16_t rqv[16];
        { const int seg_ = (tid >> 6) & 3, k_ = tid & 63;
#pragma unroll
          for (int j = 0; j < 16; ++j) rqv[j] = proj[(size_t)(rowbase + 16 * seg_ + j) * CDP + hh * 64 + k_]; }
        const u32x4 vw = *(const u32x4*)(proj + (size_t)(rowbase + (tid >> 3)) * CDP + 1536 + hh * 64 + (tid & 7) * 8);
        const u32x4 gw = *(const u32x4*)(proj + (size_t)(rowbase + (tid >> 3)) * CDP + 2048 + hh * 64 + (tid & 7) * 8);
        f32x4 sa[2], sb[2];
#pragma unroll
        for (int d = 0; d < 2; ++d) { const float* sp = HG + ((size_t)(R * 8 + hh) * 2 + d) * 4096 + (tid >> 3) * 64 + (tid & 7) * 8; sa[d] = *(const f32x4*)sp; sb[d] = *(const f32x4*)(sp + 4); }
        hgrn_gates(P, proj, rowbase, hh, tid, segtot, gmids, gc, kin, gtot, gmid);
        const int dir = tid >> 8, seg = (tid >> 6) & 3, k = tid & 63;
#pragma unroll
        for (int j = 0; j < 16; ++j) { const int t = 16 * seg + j; const float q = silu(bf2f(rqv[j]));
            *(LAS bf16_t*)(Qg + (dir * 64 + t) * HS + 2 * k) = f2bf(q * __expf(fminf(gc[j] - gmid, 80.f)));
            *(LAS bf16_t*)(Kg + (dir * 64 + t) * HS + 2 * k) = f2bf(kin[j] * __expf(fminf(gmid - gc[j], 80.f))); }
        { const int s = tid >> 3, v8 = (tid & 7) * 8; const u32x4 w = vw;
          const unsigned ww[4] = {w.x, w.y, w.z, w.w}; const int sp = swap23(s);
#pragma unroll
          for (int i = 0; i < 8; ++i) *(LAS bf16_t*)(VTl + (v8 + i) * HS + 2 * sp) = (bf16_t)((ww[i >> 1] >> ((i & 1) * 16)) & 0xffffu); }
#pragma unroll
        for (int d = 0; d < 2; ++d) { const int v = tid >> 3, k8 = (tid & 7) * 8;
            const f32x4 a = sa[d], b = sb[d]; const LAS float* gm = gmids + d * 64 + k8;
            u32x4 w; w.x = pk2(a.x * __expf(gm[0]), a.y * __expf(gm[1])); w.y = pk2(a.z * __expf(gm[2]), a.w * __expf(gm[3])); w.z = pk2(b.x * __expf(gm[4]), b.y * __expf(gm[5])); w.w = pk2(b.z * __expf(gm[6]), b.w * __expf(gm[7]));
            *(LAS u32x4*)(Sg + (d * 64 + v) * HS + 2 * k8) = w; }
        __syncthreads();
        const int wd = wave >> 2, tb = (wave >> 1) & 1, vb = wave & 1;
        f32x16 acc;
        { f32x16 p0, p1;
#pragma unroll
          for (int r = 0; r < 16; ++r) { p0[r] = 0.f; p1[r] = 0.f; acc[r] = 0.f; }
          const LAS unsigned char* kp = Kg + (wd * 64 + r32) * HS + 16 * h; const LAS unsigned char* qp = Qg + (wd * 64 + 32 * tb + r32) * HS + 16 * h;
          bf16x8 qf[4];
#pragma unroll
          for (int ks = 0; ks < 4; ++ks) qf[ks] = *(const LAS bf16x8*)(qp + 32 * ks);
#pragma unroll
          for (int ks = 0; ks < 4; ++ks) { p0 = MFMA32(*(const LAS bf16x8*)(kp + 32 * ks), qf[ks], p0); p1 = MFMA32(*(const LAS bf16x8*)(kp + 32 * HS + 32 * ks), qf[ks], p1); }
          const int t = 32 * tb + r32;
#pragma unroll
          for (int r = 0; r < 16; ++r) { const int s0 = (r & 3) + 8 * (r >> 2) + 4 * h, s1 = s0 + 32;
              const bool ok0 = wd == 0 ? (s0 <= t) : (s0 >= t), ok1 = wd == 0 ? (s1 <= t) : (s1 >= t); p0[r] = ok0 ? p0[r] : 0.f; p1[r] = ok1 ? p1[r] : 0.f; }
          bf16x8 pb[4]; pb[0] = pack8(p0, 0); pb[1] = pack8(p0, 8); pb[2] = pack8(p1, 0); pb[3] = pack8(p1, 8);
          const LAS unsigned char* vp = VTl + (32 * vb + r32) * HS + 16 * h; const LAS unsigned char* sp = Sg + (wd * 64 + 32 * vb + r32) * HS + 16 * h;
#pragma unroll
          for (int ks = 0; ks < 4; ++ks) { acc = MFMA32(*(const LAS bf16x8*)(vp + 32 * ks), pb[ks], acc); acc = MFMA32(*(const LAS bf16x8*)(sp + 32 * ks), qf[ks], acc); } }
        { const int t = 32 * tb + r32;
          if (wd == 0) {
#pragma unroll
              for (int r = 0; r < 16; ++r) Os[t * 65 + 32 * vb + (r & 3) + 8 * (r >> 2) + 4 * h] = acc[r]; }
          __syncthreads();
          if (wd == 1) {
#pragma unroll
              for (int r = 0; r < 16; ++r) Os[t * 65 + 32 * vb + (r & 3) + 8 * (r >> 2) + 4 * h] += acc[r]; }
          __syncthreads(); }
        { const int t = tid >> 3, v8 = (tid & 7) * 8; float o[8]; float ss = 0.f;
#pragma unroll
          for (int i = 0; i < 8; ++i) { o[i] = Os[t * 65 + v8 + i]; ss += o[i] * o[i]; }
          ss += SHX(ss, 1); ss += SHX(ss, 2); ss += SHX(ss, 4);
          const float rs = rsqrtf(ss * (1.f / 64.f) + EPS);
          const unsigned gg[4] = {gw.x, gw.y, gw.z, gw.w};
          float y[8];
#pragma unroll
          for (int i = 0; i < 8; ++i) { const float gate = __uint_as_float(((gg[i >> 1] >> ((i & 1) * 16)) & 0xffffu) << 16); y[i] = o[i] * rs * P.in[20][v8 + i] * silu(gate); }
          u32x4 w; w.x = pk2(y[0], y[1]); w.y = pk2(y[2], y[3]); w.z = pk2(y[4], y[5]); w.w = pk2(y[6], y[7]);
          *(u32x4*)(H + (size_t)(rowbase + t) * DM + hh * 64 + v8) = w; }
        __syncthreads();
    }
}

DI void gemm_up(const Params& P, LAS unsigned char* lds, int slot, int M, int tid) {
    pg8::Gemm g{(const bf16_t*)(P.ws + WS_H), (const bf16_t*)(P.ws + WS_FFN0 + slot * FFN_SLOT), M, 2 * FF, DM, DM};
    pg8::StaticOrder S; S.init(M, 2 * FF, gridDim.x, blockIdx.x);
    pg8::EpiSwiglu E{(bf16_t*)(P.ws + WS_U), FF};
    pg8::gemm_phase<pg8::EpiSwiglu, pg8::StaticOrder, true, true>(lds, g, S, E, tid);
}
DI void gemm_res(const Params& P, LAS unsigned char* lds, const bf16_t* A, const bf16_t* Bt, int M, int K, bool first, const float* coefL, const float* coefC, float mult, int tid) {
    float* xc = (float*)(P.ws + WS_XC);
    {
        pg8::Gemm g{A, Bt, SEQ, DM, K, K};
        pg8::StaticOrder S; S.init(SEQ, DM, gridDim.x, blockIdx.x);
        pg8::EpiResidual E{first ? P.in[0] : (const float*)P.out, nullptr, P.out, nullptr, coefL, nullptr, mult};
        pg8::gemm_phase<pg8::EpiResidual, pg8::StaticOrder, true, true>(lds, g, S, E, tid);
    }
    if (M > SEQ) {
        const int nsplit = K / 256, c = blockIdx.x, ks = c >> 2;
        pg8::Gemm g{A + (size_t)SEQ * K + ks * 256, Bt + ks * 256, CTX, DM, 256, K};
        pg8::OneUnitOrder S{c, 4 * nsplit};
        pg8::EpiPartCtx E{(float*)(P.ws + WS_PART) + (size_t)ks * CTX * DM, coefC, mult};
        pg8::gemm_phase<pg8::EpiPartCtx, pg8::OneUnitOrder, true, true>(lds, g, S, E, tid);
    }
}
DI void gemm_store(const Params& P, LAS unsigned char* lds, const bf16_t* Bt, int N, bf16_t* O, int tid) {
    pg8::Gemm g{(const bf16_t*)(P.ws + WS_H), Bt, MT, N, DM, DM};
    pg8::StaticOrder S; S.init(MT, N, gridDim.x, blockIdx.x);
    pg8::EpiStoreBf16 E{O, N};
    pg8::gemm_phase<pg8::EpiStoreBf16, pg8::StaticOrder, true, true>(lds, g, S, E, tid);
}
#define XB_TMO      128
#define XB_XCNT(j)  (256  + 64 * (j))
#define XB_XSUB(j)  (1280 + 64 * (j))
#define XB_XGEN(j)  (2304 + 64 * (j))
#define XB_TOP      3328
#define XB_TOPGEN   3392
#define XCD_BAR_WORDS 3456
#define XB_SPIN_CAP (1u << 18)

__device__ __forceinline__ unsigned xb_ld(unsigned* p)              { return __hip_atomic_load(p, __ATOMIC_RELAXED, __HIP_MEMORY_SCOPE_AGENT); }
__device__ __forceinline__ unsigned xb_add(unsigned* p, unsigned v) { return __hip_atomic_fetch_add(p, v, __ATOMIC_RELAXED, __HIP_MEMORY_SCOPE_AGENT); }
__device__ __forceinline__ unsigned xb_xcc_id() { return (unsigned)__builtin_amdgcn_s_getreg((3 << 11) | 20) & 0xFu; }
#define XB_SPIN(cond, bar) do { unsigned _sp = 0; while (cond) { __builtin_amdgcn_s_sleep(1); \
    if ((++_sp & 255u) == 0u) { if (xb_ld(&(bar)[XB_TMO])) break; if (_sp > XB_SPIN_CAP) { atomicAdd(&(bar)[XB_TMO], 1u); break; } } } } while (0)

struct XcdBarrier {
    unsigned* bar; unsigned x;
    volatile LAS unsigned* st;
};

__device__ __forceinline__ XcdBarrier xcd_barrier_post(unsigned* bar, volatile LAS unsigned* st) {
    XcdBarrier b; b.bar = bar; b.x = xb_xcc_id(); b.st = st;
    if (threadIdx.x == 0) (void)xb_add(&bar[XB_XCNT(b.x)], 1u);
    return b;
}
__device__ __forceinline__ void xcd_barrier_complete(unsigned* bar, unsigned x, unsigned& nloc, unsigned& nx) {
    const unsigned G = gridDim.x * gridDim.y * gridDim.z;
    unsigned sum, cnt, mine, sp = 0u;
    for (;;) {
        sum = 0u; cnt = 0u; mine = 0u;
#pragma unroll
        for (unsigned j = 0; j < 16; ++j) { const unsigned c = xb_ld(&bar[XB_XCNT(j)]); sum += c; cnt += (c > 0u) ? 1u : 0u; mine = (j == x) ? c : mine; }
        if (sum == G) break;
        __builtin_amdgcn_s_sleep(1);
        if ((++sp & 255u) == 0u) { if (xb_ld(&bar[XB_TMO])) break; if (sp > XB_SPIN_CAP) { atomicAdd(&bar[XB_TMO], 1u); break; } }
    }
    nloc = mine > 0u ? mine : 1u; nx = cnt > 0u ? cnt : 1u;
}

__device__ __forceinline__ void xcd_barrier(const XcdBarrier& b) {
    asm volatile("s_waitcnt vmcnt(0)" ::: "memory");
    __syncthreads();
    if (threadIdx.x == 0) {
        unsigned* bar = b.bar;
        __builtin_amdgcn_s_waitcnt(0);
        unsigned nloc = b.st[0], nx = b.st[1];
        if (nloc == 0u) { xcd_barrier_complete(bar, b.x, nloc, nx); b.st[0] = nloc; b.st[1] = nx; }
        const unsigned old = xb_add(&bar[XB_XSUB(b.x)], 1u);
        const unsigned gen = old / nloc;
        if (old + 1u == (gen + 1u) * nloc) {
            __builtin_amdgcn_fence(__ATOMIC_RELEASE, "agent");
            asm volatile("s_waitcnt vmcnt(0)" ::: "memory");
            const unsigned og = xb_add(&bar[XB_TOP], 1u);
            const unsigned tg = og / nx;
            if (og + 1u == (tg + 1u) * nx) xb_add(&bar[XB_TOPGEN], 1u);
            else XB_SPIN(xb_ld(&bar[XB_TOPGEN]) == tg, bar);
            __builtin_amdgcn_fence(__ATOMIC_ACQUIRE, "agent");
            xb_add(&bar[XB_XGEN(b.x)], 1u);
            asm volatile("s_waitcnt vmcnt(0)" ::: "memory");
        } else {
            XB_SPIN(xb_ld(&bar[XB_XGEN(b.x)]) == gen, bar);
            __builtin_amdgcn_fence(__ATOMIC_ACQUIRE, "agent");
            asm volatile("s_waitcnt vmcnt(0)" ::: "memory");
        }
    }
    __syncthreads();
}

enum { K_PRO = 0, K_NORM, K_UP, K_RES, K_STORE, K_POSTAB, K_ATTN, K_POSTCD, K_MIX1, K_MIX2 };
__global__ void __launch_bounds__(512, 2) mega(Params P0) {
    extern __shared__ __attribute__((aligned(16))) unsigned char lds_raw[];
    LAS unsigned char* lds = (LAS unsigned char*)lds_raw;
    cg::grid_group grid = cg::this_grid();
    const int wave_s = __builtin_amdgcn_readfirstlane(threadIdx.x >> 6);
    volatile LAS unsigned* barst = (volatile LAS unsigned*)(lds + LDS_BARST);
    if (threadIdx.x < 2) barst[threadIdx.x] = 0u;
    __syncthreads();
    (void)xcd_barrier_post((unsigned*)(P0.ws + WS_BAR), barst);
    for (int step = P0.ph_lo; step < P0.ph_hi; ++step) {
        Params P = P0;
        { __attribute__((address_space(1))) unsigned char* g_ = (__attribute__((address_space(1))) unsigned char*)P0.ws; asm volatile("" : "+s"(g_)); P.ws = (unsigned char*)g_; }
        { __attribute__((address_space(1))) float* g_ = (__attribute__((address_space(1))) float*)P0.out; asm volatile("" : "+s"(g_)); P.out = (float*)g_; }
#pragma unroll
        for (int i_ = 0; i_ < 25; ++i_) { const __attribute__((address_space(1))) float* g_ = (const __attribute__((address_space(1))) float*)P0.in[i_]; asm volatile("" : "+s"(g_)); P.in[i_] = (const float*)g_; }
#ifdef DUP_PH
        const int ph = step <= DUP_PH ? step : step - 1;
        const bool second = step == DUP_PH + 1;
#else
        const int ph = step; const bool second = false;
#endif
        int lane; asm volatile("v_mbcnt_lo_u32_b32 %0, -1, 0\n\tv_mbcnt_hi_u32_b32 %0, -1, %0" : "=v"(lane));
        const int wave = wave_s, tid = wave * 64 + lane;
        const float* modx = (const float*)(P.ws + WS_MODX); const float* modc = (const float*)(P.ws + WS_MODC);
        const int l = ph >= 12 ? 1 : 0;
        const int M = ph >= 20 ? SEQ : MT;
        int kind;
        switch (ph) {
        case 0: kind = K_PRO; break;
        case 1: case 4: case 9: case 12: case 15: case 21: kind = K_NORM; break;
        case 2: case 10: case 13: case 22: kind = K_UP; break;
        case 3: case 8: case 11: case 14: case 20: case 23: kind = K_RES; break;
        case 5: case 16: kind = K_STORE; break;
        case 6: kind = K_POSTAB; break;
        case 7: kind = K_ATTN; break;
        case 17: kind = K_POSTCD; break;
        case 18: kind = K_MIX1; break;
        default: kind = K_MIX2; break;
        }
        if (kind == K_PRO) phase_prologue(P, lds, tid, wave, lane, second);
        else if (kind == K_NORM) {
            const int idx = (ph == 1 || ph == 12) ? 0 : ((ph == 4 || ph == 15) ? 1 : 2);
            phase_normmod(P, l, idx, ph == 1, M, (ph == 1 || ph == 21) ? 0 : (ph == 9 ? 4 : 11), wave, lane);
            if (ph == 4 || ph == 21) { LAS float* scr = (LAS float*)(lds + wave * 16384); const int j = ph == 4 ? 0 : 1;
                for (int it = blockIdx.x * 8 + wave; it < FFN_ITEMS; it += gridDim.x * 8) convert_ffn_item(P, 1, j, j, it, scr, lane); }
        }
        else if (kind == K_UP) gemm_up(P, lds, (ph == 10 || ph == 22) ? 1 : 0, M, tid);
        else if (kind == K_RES) {
            const bool ffn = !(ph == 8 || ph == 20); const int slot = (ph == 11 || ph == 23) ? 1 : 0; const int ci = ffn ? (slot ? 8 : 2) : 5;
            const bf16_t* A = ffn ? (const bf16_t*)(P.ws + WS_U) : (const bf16_t*)(P.ws + WS_H);
            const bf16_t* Bt = ffn ? (const bf16_t*)(P.ws + WS_FFN0 + slot * FFN_SLOT + FFN_W2OFF) : (const bf16_t*)(P.ws + (ph == 8 ? WS_WOUTAB : WS_WOUTCD));
            gemm_res(P, lds, A, Bt, M, ffn ? FF : DM, ph == 3, modx + l * 9216 + ci * DM, modc + l * 9216 + ci * DM, ffn ? 0.5f : 1.0f, tid);
        }
        else if (kind == K_STORE) { if (ph == 5) gemm_store(P, lds, (const bf16_t*)(P.ws + WS_WINAB), ABP, (bf16_t*)(P.ws + WS_PROJAB), tid);
                                    else gemm_store(P, lds, (const bf16_t*)(P.ws + WS_WINCD), CDP, (bf16_t*)(P.ws + WS_PROJCD), tid); }
        else if (kind == K_POSTAB) phase_postAB(P, lds, tid, wave, lane, second);
        else if (kind == K_ATTN) phase_attn(P, lds, tid, wave, lane, second);
        else if (kind == K_POSTCD) {
#ifdef PROBE_ALT
            phase_postCD(P, lds, tid, wave, lane, second); if (!second) phase_hgrn1(P, lds, tid, wave, lane);
#else
            if (!second) phase_postCD(P, lds, tid, wave, lane, false); phase_hgrn1(P, lds, tid, wave, lane);
#endif
        }
        else if (kind == K_MIX1) {
#ifdef PROBE_ALT
            phase_hgrn2(P, tid, second); if (!second) phase_na(P, lds, tid, wave, lane);
#else
            if (!second) phase_hgrn2(P, tid, false); phase_na(P, lds, tid, wave, lane);
#endif
        }
        else phase_hgrn3(P, lds, tid, wave, lane);
        if (step + 1 < P.ph_hi) { if (step == P0.ph_lo) grid.sync(); else { XcdBarrier xb_; xb_.bar = (unsigned*)(P.ws + WS_BAR); xb_.x = xb_xcc_id(); xb_.st = (volatile LAS unsigned*)(lds + LDS_BARST); xcd_barrier(xb_); } }
    }
}

extern "C" void kernel_launch(void* const* d_in, const int* in_sizes, int n_in, void* d_out, int out_size, void* d_ws, size_t ws_size, hipStream_t stream) {
    static int grid = 0;
    if (grid == 0) {
        if (n_in != 25 || out_size != SEQ * DM || ws_size < WS_END) { fprintf(stderr, "kernel_launch: unexpected shapes n_in %d out %d ws %zu\n", n_in, out_size, ws_size); grid = -1; return; }
        int dev = 0, cus = 0, per_cu = 0;
        hipGetDevice(&dev); hipDeviceGetAttribute(&cus, hipDeviceAttributeMultiprocessorCount, dev);
        if (hipFuncSetAttribute((const void*)mega, hipFuncAttributeMaxDynamicSharedMemorySize, LDS_BYTES) != hipSuccess) { fprintf(stderr, "hipFuncSetAttribute failed\n"); grid = -1; return; }
        hipOccupancyMaxActiveBlocksPerMultiprocessor(&per_cu, (const void*)mega, 512, LDS_BYTES);
        if (per_cu < 1) { fprintf(stderr, "occupancy query says %d\n", per_cu); per_cu = 1; }
        (void)hipGetLastError();
        grid = cus;
    }
    if (grid < 0) return;
    hipMemsetAsync((char*)d_ws, 0, CTL_ZERO_BYTES, stream);
    Params p{};
    for (int i = 0; i < 25; ++i) p.in[i] = (const float*)d_in[i];
    p.out = (float*)d_out; p.ws = (unsigned char*)d_ws;
#if N_LAUNCH_MODE == 1
    for (int ph = 0; ph < NPH; ++ph) { p.ph_lo = ph; p.ph_hi = ph + 1; hipLaunchKernelGGL(mega, dim3(grid), dim3(512), LDS_BYTES, stream, p); }
#else
    p.ph_lo = 0; p.ph_hi = NPH;
    void* args[] = {&p};
    hipError_t e = hipLaunchCooperativeKernel((const void*)mega, dim3(grid), dim3(512), args, LDS_BYTES, stream);
    if (e != hipSuccess) fprintf(stderr, "cooperative launch failed: %s (grid %d)\n", hipGetErrorString(e), grid);
#endif
}
```

```cpp
#include <hip/hip_runtime.h>
#include <hip/hip_cooperative_groups.h>
#include <cstdio>
#include <cstdint>
namespace cg = cooperative_groups;
#ifndef NAIVE_ATTN
#define NAIVE_ATTN 0
#endif
#ifndef NAIVE_MIX
#define NAIVE_MIX 0
#endif
#ifndef N_LAUNCH_MODE
#define N_LAUNCH_MODE 0
#endif
namespace pg8 {
#define PG8_LAS __attribute__((address_space(3)))
typedef unsigned short bf16_t;
typedef short bf16x8 __attribute__((ext_vector_type(8)));
typedef float f32x4 __attribute__((ext_vector_type(4)));
typedef unsigned u32x4 __attribute__((ext_vector_type(4)));
typedef unsigned u32x2 __attribute__((ext_vector_type(2)));
constexpr int BM = 256, BK = 64, HALF = 128, HTB = HALF * BK * 2, STAGE_BYTES = 8 * HTB, NXCD = 8, WGM = 8;
__host__ __device__ __forceinline__ int lds_byte(int r, int c) { const int st = (r >> 4) * 2 + (c >> 5), rr = r & 15, cc = c & 31, ob = rr * 64 + cc * 2; return st * 1024 + (ob ^ (((ob >> 9) & 1) << 5)); }
__host__ __device__ __forceinline__ void stage_rc(int b, int& R, int& C) { const int st = b / 1024, sb = b % 1024, swz = sb ^ (((sb >> 9) & 1) << 5); R = (st >> 1) * 16 + swz / 64; C = (st & 1) * 32 + (swz % 64) / 2; }
__host__ __device__ __forceinline__ int perm32(int rho) { const int n = rho >> 4, i = rho & 15; return 8 * (i >> 2) + 4 * n + (i & 3); }
struct Unit { int pm, pn; };
struct Gemm { const bf16_t* A; const bf16_t* Bt; int M, N, K, ld; };
struct StaticOrder {
    int nM, nN, nwg, G, c;
    __host__ __device__ void init(int M, int N, int G_, int c_) { nM = M / BM; nN = N / BM; nwg = nM * nN; G = G_; c = c_; }
    __host__ __device__ bool next(int i, Unit& u) const {
        const long L = (long)i * G + c; if (L >= nwg) return false;
        int wgid = (int)L; { const int q = nwg / NXCD, r = nwg % NXCD, xcd = wgid % NXCD, off = wgid / NXCD; wgid = (xcd < r ? xcd * (q + 1) : r * (q + 1) + (xcd - r) * q) + off; }
        const int nig = WGM * nN, gid = wgid / nig, fm = gid * WGM, gsz = (nM - fm) < WGM ? (nM - fm) : WGM;
        u.pm = fm + ((wgid % nig) % gsz); u.pn = (wgid % nig) / gsz; return true;
    }
    __device__ __forceinline__ void a_ready(const Unit&) const {}
    __device__ __forceinline__ void done(const Unit&) const {}
};
__device__ __forceinline__ unsigned cvt_pk_bf16(float lo, float hi) { unsigned r; asm volatile("v_cvt_pk_bf16_f32 %0, %1, %2" : "=v"(r) : "v"(lo), "v"(hi)); return r; }
__device__ __forceinline__ float silu_f(float x) { return x * __builtin_amdgcn_rcpf(1.0f + __expf(-x)); }

struct EpiSwiglu {
    static constexpr bool PERM = true, AFTER_DRAIN = false;
    bf16_t* U; int ldu;
    __device__ __forceinline__ void operator()(const f32x4 (&acc)[2][2][4][2], const Unit& u, int wr, int wc, int fr, int fq) const {
        const int row0 = u.pm * BM + wr * 64 + fr, ff0 = u.pn * 128 + wc * 32 + 8 * fq;
#pragma unroll
        for (int ai = 0; ai < 2; ++ai)
#pragma unroll
            for (int m = 0; m < 4; ++m) { bf16_t* rowp = U + (size_t)(row0 + ai * HALF + m * 16) * ldu + ff0;
                const f32x4 a0 = acc[ai][0][m][0], a1 = acc[ai][0][m][1], b0 = acc[ai][1][m][0], b1 = acc[ai][1][m][1];
                u32x4 w; w.x = cvt_pk_bf16(silu_f(a0[0]) * b0[0], silu_f(a0[1]) * b0[1]); w.y = cvt_pk_bf16(silu_f(a0[2]) * b0[2], silu_f(a0[3]) * b0[3]);
                w.z = cvt_pk_bf16(silu_f(a1[0]) * b1[0], silu_f(a1[1]) * b1[1]); w.w = cvt_pk_bf16(silu_f(a1[2]) * b1[2], silu_f(a1[3]) * b1[3]);
                *(u32x4*)rowp = w; }
    }
};
struct EpiResidual {
    static constexpr bool PERM = true, AFTER_DRAIN = false;
    const float* baseL; const float* baseC; float* outL; float* outC; const float* coefL; const float* coefC; float mult;
    __device__ __forceinline__ void operator()(const f32x4 (&acc)[2][2][4][2], const Unit& u, int wr, int wc, int fr, int fq) const {
        const bool isC = u.pm >= 64;
        const float* base = isC ? baseC : baseL; float* out = isC ? outC : outL; const float* coef = isC ? coefC : coefL;
        const int row0 = (isC ? (u.pm - 64) : u.pm) * BM + wr * 64 + fr, col0 = u.pn * BM + wc * 32 + 8 * fq;
        f32x4 cf[2][2];
#pragma unroll
        for (int bj = 0; bj < 2; ++bj)
#pragma unroll
            for (int n = 0; n < 2; ++n) cf[bj][n] = *(const f32x4*)(coef + col0 + bj * HALF + 4 * n) * mult;
#pragma unroll
        for (int ai = 0; ai < 2; ++ai)
#pragma unroll
            for (int m = 0; m < 4; ++m) { const size_t off = (size_t)(row0 + ai * HALF + m * 16) * 1024 + col0;
#pragma unroll
                for (int bj = 0; bj < 2; ++bj)
#pragma unroll
                    for (int n = 0; n < 2; ++n) { const f32x4 b = *(const f32x4*)(base + off + bj * HALF + 4 * n);
                        *(f32x4*)(out + off + bj * HALF + 4 * n) = b + cf[bj][n] * acc[ai][bj][m][n]; } }
    }
};
struct EpiPartCtx {
    static constexpr bool PERM = true, AFTER_DRAIN = false;
    float* part; const float* coef; float mult;
    __device__ __forceinline__ void operator()(const f32x4 (&acc)[2][2][4][2], const Unit& u, int wr, int wc, int fr, int fq) const {
        const int row0 = wr * 64 + fr, col0 = u.pn * BM + wc * 32 + 8 * fq;
        f32x4 cf[2][2];
#pragma unroll
        for (int bj = 0; bj < 2; ++bj)
#pragma unroll
            for (int n = 0; n < 2; ++n) cf[bj][n] = *(const f32x4*)(coef + col0 + bj * HALF + 4 * n) * mult;
#pragma unroll
        for (int ai = 0; ai < 2; ++ai)
#pragma unroll
            for (int m = 0; m < 4; ++m) { float* rp = part + (size_t)(row0 + ai * HALF + m * 16) * 1024 + col0;
#pragma unroll
                for (int bj = 0; bj < 2; ++bj)
#pragma unroll
                    for (int n = 0; n < 2; ++n) *(f32x4*)(rp + bj * HALF + 4 * n) = cf[bj][n] * acc[ai][bj][m][n]; }
    }
};
struct OneUnitOrder {
    int c, n;
    __device__ __forceinline__ bool next(int i, Unit& u) const { if (i > 0 || c >= n) return false; u.pm = 0; u.pn = c & 3; return true; }
    __device__ __forceinline__ void a_ready(const Unit&) const {}
    __device__ __forceinline__ void done(const Unit&) const {}
};
struct EpiStoreBf16 {
    static constexpr bool PERM = true, AFTER_DRAIN = false;
    bf16_t* O; int ldc;
    __device__ __forceinline__ void operator()(const f32x4 (&acc)[2][2][4][2], const Unit& u, int wr, int wc, int fr, int fq) const {
        const int row0 = u.pm * BM + wr * 64 + fr, col0 = u.pn * BM + wc * 32 + 8 * fq;
#pragma unroll
        for (int ai = 0; ai < 2; ++ai)
#pragma unroll
            for (int m = 0; m < 4; ++m) { bf16_t* rowp = O + (size_t)(row0 + ai * HALF + m * 16) * ldc + col0;
#pragma unroll
                for (int bj = 0; bj < 2; ++bj) { const f32x4 v0 = acc[ai][bj][m][0], v1 = acc[ai][bj][m][1];
                    u32x4 w; w.x = cvt_pk_bf16(v0[0], v0[1]); w.y = cvt_pk_bf16(v0[2], v0[3]); w.z = cvt_pk_bf16(v1[0], v1[1]); w.w = cvt_pk_bf16(v1[2], v1[3]);
                    *(u32x4*)(rowp + bj * HALF) = w; } }
    }
};
template <class Epi, class Sched, bool ALIGN_EPI = false, bool SP2 = false>
__device__ __forceinline__ void gemm_phase(PG8_LAS unsigned char* lds, const Gemm g, const Sched& S, const Epi& E, const int tid) {
    const int wid = __builtin_amdgcn_readfirstlane(tid >> 6), lane = tid & 63, wr = wid >> 2, wc = wid & 3, fr = lane & 15, fq = lane >> 4;
    const int K = g.K, nt = K / BK;
    unsigned voffA[2], voffB[2];
#pragma unroll
    for (int i = 0; i < 2; ++i) { int R, C; stage_rc(tid * 16 + i * 8192, R, C); const int Rb = Epi::PERM ? ((R & ~31) + perm32(R & 31)) : R;
        voffA[i] = (unsigned)(R * g.ld + C) * 2u; voffB[i] = (unsigned)(Rb * g.ld + C) * 2u; }
    const size_t kstep = (size_t)(BK * 2);
    const size_t hstep = (size_t)HALF * g.ld * 2;
    const size_t tstep = 2 * hstep;
    const unsigned ldsw = (unsigned)wid * 1024u;
    const int aoff = lds_byte(wr * 64 + fr, fq * 8), boff = lds_byte(wc * 32 + fr, fq * 8);
#define PG8_SA(b, h) (((b) * 2 + (h)) * HTB)
#define PG8_SB(b, h) ((4 + (b) * 2 + (h)) * HTB)
#define PG8_STAGE(bufoff, gbase, voff) do { _Pragma("unroll") for (int _i = 0; _i < 2; ++_i) \
        __builtin_amdgcn_global_load_lds((const unsigned*)((const char*)(gbase) + (voff)[_i]), (PG8_LAS unsigned*)(lds + (bufoff) + ldsw + _i * 8192), 16, 0, 0); } while (0)
#define PG8_LDA(dst, b, h) do { _Pragma("unroll") for (int m = 0; m < 4; ++m) _Pragma("unroll") for (int k = 0; k < 2; ++k) dst[m][k] = *(const PG8_LAS bf16x8*)(lds + PG8_SA(b, h) + aoff + m * 2048 + k * 1024); } while (0)
#define PG8_LDB(dst, b, h) do { _Pragma("unroll") for (int n = 0; n < 2; ++n) _Pragma("unroll") for (int k = 0; k < 2; ++k) dst[n][k] = *(const PG8_LAS bf16x8*)(lds + PG8_SB(b, h) + boff + n * 2048 + k * 1024); } while (0)
#define PG8_MMA(ai, bj, At, Bt) do { __builtin_amdgcn_s_setprio(1); _Pragma("unroll") for (int m = 0; m < 4; ++m) _Pragma("unroll") for (int n = 0; n < 2; ++n) _Pragma("unroll") for (int k = 0; k < 2; ++k) \
        acc[ai][bj][m][n] = __builtin_amdgcn_mfma_f32_16x16x32_bf16(Bt[n][k], At[m][k], acc[ai][bj][m][n], 0, 0, 0); __builtin_amdgcn_s_setprio(0); } while (0)
#define PG8_WAIT_V(n) asm volatile("s_waitcnt vmcnt(" #n ")" ::: "memory")
#define PG8_WAIT_L(n) asm volatile("s_waitcnt lgkmcnt(" #n ")" ::: "memory")
#define PG8_BAR __builtin_amdgcn_s_barrier()
#define PG8_SCHED __builtin_amdgcn_sched_barrier(0)
    Unit cur, nxt; int ui = 0;
    if (!S.next(0, cur)) return;
    f32x4 acc[2][2][4][2];
#pragma unroll
    for (int a = 0; a < 2; ++a)
#pragma unroll
        for (int b = 0; b < 2; ++b)
#pragma unroll
            for (int m = 0; m < 4; ++m)
#pragma unroll
                for (int n = 0; n < 2; ++n) acc[a][b][m][n] = (f32x4){0.f, 0.f, 0.f, 0.f};
    bf16x8 At[4][2], B0[2][2], B1[2][2];
    const char* cA = (const char*)g.A + (size_t)cur.pm * tstep; const char* cB = (const char*)g.Bt + (size_t)cur.pn * tstep;
    S.a_ready(cur);
    if constexpr (SP2) {
        PG8_STAGE(PG8_SB(0, 0), cB, voffB); PG8_STAGE(PG8_SB(0, 1), cB + hstep, voffB); PG8_STAGE(PG8_SA(0, 0), cA, voffA); PG8_STAGE(PG8_SA(0, 1), cA + hstep, voffA);
        if (wr == 1) PG8_BAR;
        PG8_WAIT_V(2); PG8_BAR;
        PG8_STAGE(PG8_SB(1, 0), cB + kstep, voffB); PG8_STAGE(PG8_SA(1, 0), cA + kstep, voffA); PG8_STAGE(PG8_SB(1, 1), cB + hstep + kstep, voffB);
        PG8_WAIT_V(6); PG8_BAR;
    } else {
        PG8_STAGE(PG8_SB(0, 0), cB, voffB); PG8_STAGE(PG8_SA(0, 0), cA, voffA); PG8_STAGE(PG8_SB(0, 1), cB + hstep, voffB); PG8_STAGE(PG8_SA(0, 1), cA + hstep, voffA);
        if (wr == 1) PG8_BAR;
        PG8_WAIT_V(4); PG8_BAR;
        PG8_STAGE(PG8_SB(1, 0), cB + kstep, voffB); PG8_STAGE(PG8_SA(1, 0), cA + kstep, voffA); PG8_STAGE(PG8_SB(1, 1), cB + hstep + kstep, voffB);
        PG8_WAIT_V(6); PG8_BAR;
    }
    for (;;) {
        const bool has_next = S.next(ui + 1, nxt);
        const char* nA = has_next ? (const char*)g.A + (size_t)nxt.pm * tstep : cA; const char* nB = has_next ? (const char*)g.Bt + (size_t)nxt.pn * tstep : cB;
        for (int t = 0; t < nt; t += 2) {
            const bool last = (t == nt - 2);
            const char* a1 = cA + (size_t)(t + 1) * kstep;
            const char* a2 = last ? nA : cA + (size_t)(t + 2) * kstep; const char* b2 = last ? nB : cB + (size_t)(t + 2) * kstep;
            const char* a3 = a2 + kstep; const char* b3 = b2 + kstep;
            if (last && has_next) S.a_ready(nxt);
            if constexpr (SP2) {
            PG8_LDB(B0, 0, 0); PG8_LDB(B1, 0, 1); PG8_SCHED; PG8_LDA(At, 0, 0); PG8_STAGE(PG8_SA(1, 1), a1 + hstep, voffA);
            PG8_WAIT_V(8); PG8_WAIT_L(0); PG8_BAR; PG8_MMA(0, 0, At, B0); PG8_MMA(0, 1, At, B1); PG8_BAR; PG8_SCHED;
            PG8_LDA(At, 0, 1); PG8_STAGE(PG8_SB(0, 0), b2, voffB); PG8_STAGE(PG8_SB(0, 1), b2 + hstep, voffB); PG8_STAGE(PG8_SA(0, 0), a2, voffA);
            PG8_WAIT_V(8); PG8_WAIT_L(0); PG8_BAR; PG8_MMA(1, 0, At, B0); PG8_MMA(1, 1, At, B1); PG8_BAR; PG8_SCHED;
            PG8_LDB(B0, 1, 0); PG8_LDB(B1, 1, 1); PG8_SCHED; PG8_LDA(At, 1, 0); PG8_STAGE(PG8_SA(0, 1), a2 + hstep, voffA);
            PG8_WAIT_V(8); PG8_WAIT_L(0); PG8_BAR; PG8_MMA(0, 0, At, B0); PG8_MMA(0, 1, At, B1); PG8_BAR; PG8_SCHED;
            PG8_LDA(At, 1, 1); PG8_STAGE(PG8_SB(1, 0), b3, voffB); PG8_STAGE(PG8_SB(1, 1), b3 + hstep, voffB); PG8_STAGE(PG8_SA(1, 0), a3, voffA);
            PG8_WAIT_V(8); PG8_WAIT_L(0); PG8_BAR; PG8_MMA(1, 0, At, B0); PG8_MMA(1, 1, At, B1); PG8_BAR; PG8_SCHED;
            } else {
            PG8_LDB(B0, 0, 0); PG8_SCHED; PG8_LDA(At, 0, 0); PG8_STAGE(PG8_SA(1, 1), a1 + hstep, voffA);
            PG8_WAIT_L(8); PG8_BAR; PG8_WAIT_L(0); PG8_MMA(0, 0, At, B0); PG8_BAR; PG8_SCHED;
            PG8_LDB(B1, 0, 1); PG8_STAGE(PG8_SB(0, 0), b2, voffB);
            PG8_BAR; PG8_WAIT_L(0); PG8_MMA(0, 1, At, B1); PG8_BAR;
            PG8_LDA(At, 0, 1); PG8_STAGE(PG8_SA(0, 0), a2, voffA);
            PG8_BAR; PG8_WAIT_L(0); PG8_MMA(1, 0, At, B0); PG8_BAR; PG8_SCHED;
            PG8_STAGE(PG8_SB(0, 1), b2 + hstep, voffB);
            PG8_WAIT_V(6); PG8_BAR; PG8_MMA(1, 1, At, B1); PG8_BAR;
            PG8_LDB(B0, 1, 0); PG8_SCHED; PG8_LDA(At, 1, 0); PG8_STAGE(PG8_SA(0, 1), a2 + hstep, voffA);
            PG8_WAIT_L(8); PG8_BAR; PG8_WAIT_L(0); PG8_MMA(0, 0, At, B0); PG8_BAR; PG8_SCHED;
            PG8_LDB(B1, 1, 1); PG8_STAGE(PG8_SB(1, 0), b3, voffB);
            PG8_BAR; PG8_WAIT_L(0); PG8_MMA(0, 1, At, B1); PG8_BAR;
            PG8_LDA(At, 1, 1); PG8_STAGE(PG8_SA(1, 0), a3, voffA);
            PG8_BAR; PG8_WAIT_L(0); PG8_MMA(1, 0, At, B0); PG8_BAR; PG8_SCHED;
            PG8_STAGE(PG8_SB(1, 1), b3 + hstep, voffB);
            PG8_WAIT_V(6); PG8_BAR; PG8_MMA(1, 1, At, B1); PG8_BAR;
            }
        }
        if constexpr (ALIGN_EPI) { if (wr == 0) PG8_BAR; }
        if constexpr (!Epi::AFTER_DRAIN) { E(acc, cur, wr, wc, fr, fq); S.done(cur); }
        if (!has_next) break;
#pragma unroll
        for (int a = 0; a < 2; ++a)
#pragma unroll
            for (int b = 0; b < 2; ++b)
#pragma unroll
                for (int m = 0; m < 4; ++m)
#pragma unroll
                    for (int n = 0; n < 2; ++n) acc[a][b][m][n] = (f32x4){0.f, 0.f, 0.f, 0.f};
        cur = nxt; cA = nA; cB = nB; ++ui;
        if constexpr (ALIGN_EPI) { if (wr == 1) PG8_BAR; }
    }
    PG8_WAIT_V(0);
    if constexpr (!ALIGN_EPI) { if (wr == 0) PG8_BAR; }
    PG8_BAR;
    if constexpr (Epi::AFTER_DRAIN) { E.fused(acc, cur, wr, wc, fr, fq, lds, wid, lane); S.done(cur); }
#undef PG8_SA
#undef PG8_SB
#undef PG8_STAGE
#undef PG8_LDA
#undef PG8_LDB
#undef PG8_MMA
#undef PG8_WAIT_V
#undef PG8_WAIT_L
#undef PG8_BAR
#undef PG8_SCHED
}
}
#define LAS __attribute__((address_space(3)))
#define DI __device__ __forceinline__
typedef unsigned short bf16_t;
typedef float f32x4 __attribute__((ext_vector_type(4)));
typedef unsigned u32x4 __attribute__((ext_vector_type(4)));
typedef unsigned u32x2 __attribute__((ext_vector_type(2)));
constexpr int DM = 1024, SEQ = 16384, CTX = 256, MT = SEQ + CTX, FF = 2816;
constexpr int ABP = 3072, CDP = 4096, ABIN = 1824;
constexpr float EPS = 1e-6f, LOG2E = 1.4426950408889634f;
constexpr size_t MiB = 1u << 20;
constexpr size_t WS_MODX = 0, WS_MODC = 128 * 1024, CTL_ZERO_BYTES = 256 * 1024;
constexpr size_t WS_XC = 1 * MiB, WS_WINAB = 2 * MiB, WS_WOUTAB = 8 * MiB, WS_WINCD = 10 * MiB, WS_WOUTCD = 18 * MiB, WS_H = 20 * MiB;
constexpr size_t WS_FFN0 = 53 * MiB, FFN_SLOT = 16 * MiB + MiB / 2, FFN_W2OFF = 11 * MiB;
constexpr size_t WS_R = 86 * MiB, WS_U = WS_R, WS_PROJAB = WS_R, WS_VAT = 184 * MiB, WS_VBT = 189 * MiB;
constexpr size_t WS_PART = 206 * MiB;
constexpr size_t WS_HG = 53 * MiB, WS_HGD = 118 * MiB, WS_PROJCD = 120 * MiB, WS_VDT = 250 * MiB, WS_END = 267 * MiB;
constexpr size_t WS_DUMMY = 268 * MiB;
constexpr size_t WS_BAR = 80 * 1024;
constexpr int LDS_BYTES = 132 * 1024, LDS_BARST = LDS_BYTES - 16;
#ifdef DUP_PH
constexpr int NPH = 25;
#else
constexpr int NPH = 24;
#endif

struct Params { const float* in[25]; float* out; unsigned char* ws; int ph_lo, ph_hi; };

DI float bf2f(bf16_t v) { return __uint_as_float(((unsigned)v) << 16); }
DI bf16_t f2bf(float f) { unsigned u = __float_as_uint(f); return (bf16_t)((u + 0x7fffu + ((u >> 16) & 1u)) >> 16); }
DI unsigned pk2(float lo, float hi) { return (unsigned)f2bf(lo) | ((unsigned)f2bf(hi) << 16); }
#define SHX(v, o) __builtin_bit_cast(float, __builtin_amdgcn_ds_bpermute(((lane) ^ (o)) << 2, __builtin_bit_cast(int, (float)(v))))
#define DPP_ADD(v, ctrl) ((v) + __builtin_bit_cast(float, __builtin_amdgcn_update_dpp(0, __builtin_bit_cast(int, (float)(v)), (ctrl), 0xf, 0xf, false)))
DI float wave_sum(float v, int lane) {
    (void)lane;
    v = DPP_ADD(v, 0xB1); v = DPP_ADD(v, 0x4E); v = DPP_ADD(v, 0x141); v = DPP_ADD(v, 0x140);
    const int iv = __builtin_bit_cast(int, v);
    const float a = __builtin_bit_cast(float, __builtin_amdgcn_readlane(iv, 0)), b = __builtin_bit_cast(float, __builtin_amdgcn_readlane(iv, 16));
    const float c = __builtin_bit_cast(float, __builtin_amdgcn_readlane(iv, 32)), d = __builtin_bit_cast(float, __builtin_amdgcn_readlane(iv, 48));
    return (a + b) + (c + d);
}
DI float silu(float x) { return x / (1.0f + __expf(-x)); }
DI float sigmoidf_(float x) { return 1.0f / (1.0f + __expf(-x)); }
DI int swap23(int p) { return (p & ~12) | ((p & 8) >> 1) | ((p & 4) << 1); }
#define LDS_WAIT() asm volatile("s_waitcnt lgkmcnt(0)" ::: "memory")

struct SrcPlain { const float* W; int N; DI float operator()(int k, int n) const { return W[(size_t)k * N + n]; } };
struct SrcW13 { const float* w1; long d31; DI float operator()(int k, int n) const { return w1[(long)k * FF + ((n >> 8) << 7) + (n & 127) + ((n & 128) ? d31 : 0l)]; } };
template <class Src> DI void transpose_item(const Src& src, int K, bf16_t* WT, LAS float* scr, int kb, int nb, int lane) {
    const int k0 = 64 * kb, n0 = 32 * nb;
    float tv[32];
#pragma unroll
    for (int i = 0; i < 32; ++i) tv[i] = src(k0 + 2 * i + (lane >> 5), n0 + (lane & 31));
    __builtin_amdgcn_sched_barrier(0);
#pragma unroll
    for (int i = 0; i < 32; ++i) scr[(2 * i + (lane >> 5)) * 33 + (lane & 31)] = tv[i];
    LDS_WAIT();
    const int c = lane & 7;
#pragma unroll
    for (int j = 0; j < 4; ++j) { const int n = (lane >> 3) + 8 * j; const LAS float* s = scr + (8 * c) * 33 + n;
        u32x4 o; o.x = pk2(s[0 * 33], s[1 * 33]); o.y = pk2(s[2 * 33], s[3 * 33]); o.z = pk2(s[4 * 33], s[5 * 33]); o.w = pk2(s[6 * 33], s[7 * 33]);
        *(u32x4*)(WT + (size_t)(n0 + n) * K + k0 + 8 * c) = o; }
    LDS_WAIT();
}
constexpr int FFN_ITEMS = 16 * 176 + 44 * 32;
DI void convert_ffn_item(const Params& P, int l, int j, int slot, int it, LAS float* scr, int lane) {
    const size_t wo = (size_t)(l * 2 + j) * DM * FF;
    bf16_t* W13t = (bf16_t*)(P.ws + WS_FFN0 + slot * FFN_SLOT); bf16_t* W2t = (bf16_t*)(P.ws + WS_FFN0 + slot * FFN_SLOT + FFN_W2OFF);
    if (it < 16 * 176) { SrcW13 s{P.in[7] + wo, (long)(P.in[8] - P.in[7])}; transpose_item(s, DM, W13t, scr, it / 176, it % 176, lane); }
    else { it -= 16 * 176; SrcPlain s{P.in[9] + wo, DM}; transpose_item(s, FF, W2t, scr, it / 32, it % 32, lane); }
}
DI void phase_prologue(const Params& P, LAS unsigned char* lds, int tid, int wave, int lane, bool second) {
    LAS float* scr = (LAS float*)(lds + wave * 16384);
    const int gw = blockIdx.x * 8 + wave, ngw = gridDim.x * 8;
    constexpr int I_AB = 16 * 57, I_O = 16 * 32, I_CD = 16 * 128;
    constexpr int NIT = 2 * FFN_ITEMS + I_AB + I_O + I_CD + I_O;
    for (int it = gw; it < NIT; it += ngw) {
        int r = it;
        if (r < FFN_ITEMS) { convert_ffn_item(P, 0, 0, 0, r, scr, lane); continue; } r -= FFN_ITEMS;
        if (r < FFN_ITEMS) { convert_ffn_item(P, 0, 1, 1, r, scr, lane); continue; } r -= FFN_ITEMS;
        if (r < I_AB) { SrcPlain s{P.in[10], ABIN}; transpose_item(s, DM, (bf16_t*)(P.ws + WS_WINAB), scr, r / 57, r % 57, lane); continue; } r -= I_AB;
        if (r < I_O) { SrcPlain s{P.in[17], DM}; transpose_item(s, DM, (bf16_t*)(P.ws + WS_WOUTAB), scr, r / 32, r % 32, lane); continue; } r -= I_O;
        if (r < I_CD) { SrcPlain s{P.in[18], CDP}; transpose_item(s, DM, (bf16_t*)(P.ws + WS_WINCD), scr, r / 128, r % 128, lane); continue; } r -= I_CD;
        { SrcPlain s{P.in[24], DM}; transpose_item(s, DM, (bf16_t*)(P.ws + WS_WOUTCD), scr, r / 32, r % 32, lane); }
    }
    __syncthreads();
    {
        LAS float* As = (LAS float*)lds; LAS float* Bs = (LAS float*)(lds + 64 * 33 * 4);
        const float* Win = P.in[10]; const float* gk = P.in[15]; const float* wu = P.in[16];
        bf16_t* Wt = (bf16_t*)(P.ws + WS_WINAB);
        for (int t = blockIdx.x; t < 256; t += gridDim.x) {
            const int n0 = (t >> 4) * 64, k0 = (t & 15) * 64, kl = tid & 63, ng = tid >> 6;
            float acc[8];
#pragma unroll
            for (int i = 0; i < 8; ++i) acc[i] = 0.f;
            for (int jc = 0; jc < 8; ++jc) { const int j0 = jc * 32;
                { const int kk = tid >> 3, jj4 = (tid & 7) * 4, jb = tid >> 4, nn4 = (tid & 15) * 4;
                  const f32x4 av = *(const f32x4*)(Win + (size_t)(k0 + kk) * ABIN + 1536 + j0 + jj4); const f32x4 bv = *(const f32x4*)(wu + (size_t)(j0 + jb) * DM + n0 + nn4); const float gv = gk[j0 + jb];
                  As[kk * 33 + jj4] = av.x; As[kk * 33 + jj4 + 1] = av.y; As[kk * 33 + jj4 + 2] = av.z; As[kk * 33 + jj4 + 3] = av.w;
                  Bs[jb * 64 + nn4] = gv * bv.x; Bs[jb * 64 + nn4 + 1] = gv * bv.y; Bs[jb * 64 + nn4 + 2] = gv * bv.z; Bs[jb * 64 + nn4 + 3] = gv * bv.w; }
                __syncthreads();
#pragma unroll 8
                for (int jj = 0; jj < 32; ++jj) { const float a = As[kl * 33 + jj];
#pragma unroll
                    for (int i = 0; i < 8; ++i) acc[i] += a * Bs[jj * 64 + ng * 8 + i]; }
                __syncthreads();
            }
#pragma unroll
            for (int i = 0; i < 8; ++i) Wt[(size_t)(ABIN + n0 + ng * 8 + i) * DM + k0 + kl] = f2bf(acc[i]);
        }
        { u32x4* z = (u32x4*)(Wt + (size_t)2848 * DM); const int nz = 224 * DM * 2 / 16;
          unsigned zz_ = 0u; asm volatile("" : "+v"(zz_));
          for (int i = blockIdx.x * 512 + tid; i < nz; i += gridDim.x * 512) z[i] = (u32x4){zz_, zz_, zz_, zz_}; }
    }
    { const f32x4* src = (const f32x4*)P.in[2]; f32x4* dst = (f32x4*)(P.ws + WS_XC); for (int i = blockIdx.x * 512 + tid; i < CTX * DM / 4; i += gridDim.x * 512) dst[i] = src[i]; }
    {
        float* modx = (float*)(P.ws + (second ? WS_DUMMY : WS_MODX)); float* modc = (float*)(P.ws + (second ? WS_DUMMY + 128 * 1024 : WS_MODC));
        const float* cv = P.in[1]; const float* cc = P.in[3];
        for (int it = blockIdx.x; it < 2 * 18 * 8; it += gridDim.x) {
            const int l = it / (18 * 8), r = it % (18 * 8), cb = r / 8, kc = r % 8, n = cb * 512 + tid;
            float ax = 0.f, ac = 0.f;
            for (int kb = kc * 128; kb < kc * 128 + 128; kb += 32) {
                const float* w = P.in[5] + (size_t)l * DM * 9216 + (size_t)kb * 9216 + n;
                float wv[32];
#pragma unroll
                for (int kk = 0; kk < 32; ++kk) wv[kk] = w[(size_t)kk * 9216];
                __builtin_amdgcn_sched_barrier(0);
#pragma unroll
                for (int kk = 0; kk < 32; ++kk) { ax += silu(cv[kb + kk]) * wv[kk]; ac += silu(cc[kb + kk]) * wv[kk]; }
            }
            if (kc == 0) { const float b = P.in[6][l * 9216 + n]; ax += b; ac += b; }
            atomicAdd(modx + l * 9216 + n, ax); atomicAdd(modc + l * 9216 + n, ac);
        }
    }
}

DI void phase_normmod(const Params& P, int l, int idx, bool first, int nrows, int nsplit, int wave, int lane) {
    const float* g = P.in[4] + (l * 3 + idx) * DM;
    const float* modx = (const float*)(P.ws + WS_MODX) + l * 9216; const float* modc = (const float*)(P.ws + WS_MODC) + l * 9216;
    bf16_t* H = (bf16_t*)(P.ws + WS_H);
    const int gw = blockIdx.x * 8 + wave, ngw = gridDim.x * 8;
    for (int m = gw; m < nrows; m += ngw) {
        const bool isC = m >= SEQ;
        const float* src = isC ? ((first ? P.in[2] : (const float*)(P.ws + WS_XC)) + (size_t)(m - SEQ) * DM) : ((first ? P.in[0] : (const float*)P.out) + (size_t)m * DM);
        const float* mod = isC ? modc : modx; const float* shift = mod + (idx * 3) * DM; const float* scale = mod + (idx * 3 + 1) * DM;
        f32x4 v[4]; float ss = 0.f;
#pragma unroll
        for (int j = 0; j < 4; ++j) { v[j] = ((const f32x4*)src)[64 * j + lane]; ss += (v[j].x * v[j].x + v[j].y * v[j].y) + (v[j].z * v[j].z + v[j].w * v[j].w); }
        if (isC && nsplit > 0) {
            const float* part = (const float*)(P.ws + WS_PART) + (size_t)(m - SEQ) * DM; float* xc = (float*)(P.ws + WS_XC) + (size_t)(m - SEQ) * DM;
            for (int sp = 0; sp < nsplit; ++sp) {
#pragma unroll
                for (int j = 0; j < 4; ++j) v[j] += ((const f32x4*)(part + (size_t)sp * CTX * DM))[64 * j + lane]; }
            ss = 0.f;
#pragma unroll
            for (int j = 0; j < 4; ++j) { ((f32x4*)xc)[64 * j + lane] = v[j]; ss += (v[j].x * v[j].x + v[j].y * v[j].y) + (v[j].z * v[j].z + v[j].w * v[j].w); }
        }
        ss = wave_sum(ss, lane); const float rstd = rsqrtf(ss * (1.0f / DM) + EPS);
#pragma unroll
        for (int j = 0; j < 4; ++j) { const int col = 4 * (64 * j + lane);
            const f32x4 gv = *(const f32x4*)(g + col), sc = *(const f32x4*)(scale + col), sh = *(const f32x4*)(shift + col);
            const f32x4 y = (v[j] * rstd * gv) * (sc + 1.0f) + sh;
            u32x2 w; w.x = pk2(y.x, y.y); w.y = pk2(y.z, y.w); *(u32x2*)(H + (size_t)m * DM + col) = w; }
    }
}

DI void phase_postAB(const Params& P, LAS unsigned char* lds, int tid, int wave, int lane, bool second) {
    bf16_t* proj = (bf16_t*)(P.ws + WS_PROJAB); bf16_t* VAT = (bf16_t*)(P.ws + WS_VAT); bf16_t* VBT = (bf16_t*)(P.ws + WS_VBT);
    LAS bf16_t* vt = (LAS bf16_t*)lds; constexpr int VTS = 18;
    const float aqn = P.in[11][lane], akn = P.in[12][lane], bqn0 = P.in[13][lane], bqn1 = P.in[13][64 + (lane & 31)], bkn0 = P.in[14][lane], bkn1 = P.in[14][64 + (lane & 31)];
    const float invA = exp2f(-(float)(lane & 15) * (13.287712379549449f / 16.0f)), invB = exp2f(-(float)(lane & 7) * (13.287712379549449f / 8.0f));
    const float sgnA = (lane & 16) ? 1.f : -1.f, sgnB = (lane & 8) ? 1.f : -1.f;
    const float qsA = 0.125f * LOG2E, qsB = 0.10206207261596577f * LOG2E;
    const bool lo = lane < 32;
    for (int tile = blockIdx.x; tile < MT / 16; tile += gridDim.x) {
        for (int i = 0; i < 2; ++i) {
            const int tt = wave * 2 + i, m = tile * 16 + tt, pp = swap23(tt); const bool rot = m < SEQ;
            bf16_t* raw = proj + (size_t)m * ABP;
            const bf16_t* rawi = raw; if (second) raw = (bf16_t*)(P.ws + WS_DUMMY) + (size_t)(m & 1023) * ABP;
            bf16_t rq[8], rk[2], rbq0[8], rbq1[8], rl[4], rkn[8], rvv[8], xv[2], rkr;
#pragma unroll
            for (int hh = 0; hh < 8; ++hh) { rq[hh] = rawi[hh * 64 + lane]; rbq0[hh] = rawi[768 + hh * 96 + lane]; rbq1[hh] = rawi[768 + hh * 96 + 64 + (lane & 31)];
                rkn[hh] = rawi[ABIN + hh * 128 + lane]; rvv[hh] = rawi[ABIN + hh * 128 + 64 + lane]; }
#pragma unroll
            for (int hh = 0; hh < 2; ++hh) { rk[hh] = rawi[512 + hh * 64 + lane]; xv[hh] = rawi[640 + hh * 64 + lane]; }
#pragma unroll
            for (int j = 0; j < 4; ++j) rl[j] = rawi[1536 + 64 * j + lane];
            rkr = rawi[1792 + (lane & 31)];
            __builtin_amdgcn_sched_barrier(0);
            float xq[8], xk[2], xbq0[8], xbq1[8], xl[4], xkn[8], xvv[8];
#pragma unroll
            for (int hh = 0; hh < 8; ++hh) { xq[hh] = bf2f(rq[hh]); xbq0[hh] = bf2f(rbq0[hh]); xbq1[hh] = lo ? bf2f(rbq1[hh]) : 0.f; xkn[hh] = bf2f(rkn[hh]); xvv[hh] = bf2f(rvv[hh]); }
#pragma unroll
            for (int hh = 0; hh < 2; ++hh) xk[hh] = bf2f(rk[hh]);
#pragma unroll
            for (int j = 0; j < 4; ++j) xl[j] = bf2f(rl[j]);
            const float kr = lo ? bf2f(rkr) : 0.f;
            const float pr = (float)(m >> 6), pc = (float)(m & 63);
            float cA = 1.f, sA = 0.f, cB = 1.f, sB = 0.f;
            if (rot) { const float angA = ((lane & 32) ? pc : pr) * invA, angB = ((lane & 16) ? pc : pr) * invB; cA = cosf(angA); sA = sinf(angA); cB = cosf(angB); sB = sinf(angB); }
#pragma unroll
            for (int hh = 0; hh < 8; ++hh) { const float x = xq[hh]; const float ss = wave_sum(x * x, lane);
                float y = x * rsqrtf(ss * (1.f / 64.f) + EPS) * aqn; const float pt = SHX(y, 16); y = y * cA + sgnA * pt * sA; raw[hh * 64 + lane] = f2bf(y * qsA); }
#pragma unroll
            for (int hh = 0; hh < 2; ++hh) { const float x = xk[hh]; const float ss = wave_sum(x * x, lane);
                float y = x * rsqrtf(ss * (1.f / 64.f) + EPS) * akn; const float pt = SHX(y, 16); y = y * cA + sgnA * pt * sA; raw[512 + hh * 64 + lane] = f2bf(y);
                vt[(hh * 64 + lane) * VTS + pp] = xv[hh]; }
#pragma unroll
            for (int hh = 0; hh < 8; ++hh) { const float x0 = xbq0[hh], x1 = xbq1[hh];
                const float ss = wave_sum(x0 * x0 + x1 * x1, lane); const float rs = rsqrtf(ss * (1.f / 96.f) + EPS);
                const float y0 = x0 * rs * bqn0; float y1 = x1 * rs * bqn1; const float pt = SHX(y1, 8); y1 = y1 * cB + sgnB * pt * sB;
                raw[768 + hh * 96 + lane] = f2bf(y0 * qsB); if (lo) raw[768 + hh * 96 + 64 + lane] = f2bf(y1 * qsB); }
            const float rkv = rsqrtf(wave_sum(xl[0] * xl[0] + xl[1] * xl[1] + xl[2] * xl[2] + xl[3] * xl[3], lane) * (1.f / 256.f) + EPS);
#pragma unroll
            for (int hh = 0; hh < 8; ++hh) { const float kn = xkn[hh] * rkv; const float vv = xvv[hh] * rkv;
                const float ss = wave_sum(kn * kn + kr * kr, lane); const float rs = rsqrtf(ss * (1.f / 96.f) + EPS);
                const float y0 = kn * rs * bkn0; float y1 = kr * rs * bkn1; const float pt = SHX(y1, 8); y1 = y1 * cB + sgnB * pt * sB;
                raw[ABIN + hh * 128 + lane] = f2bf(y0); if (lo) raw[ABIN + hh * 128 + 64 + lane] = f2bf(y1);
                vt[(128 + hh * 64 + lane) * VTS + pp] = f2bf(vv); }
        }
        __syncthreads();
        for (int c = tid; c < 640 * 2; c += 512) { const int row = c >> 1, c8 = c & 1; const LAS unsigned* s = (const LAS unsigned*)(vt + row * VTS + 8 * c8);
            u32x4 o; o.x = s[0]; o.y = s[1]; o.z = s[2]; o.w = s[3];
            bf16_t* dst = row < 128 ? VAT + (size_t)row * MT : VBT + (size_t)(row - 128) * MT;
            if (second) dst = (bf16_t*)(P.ws + WS_DUMMY + 8 * MiB) + (size_t)row * 1024 - tile * 16 + (tile & 31) * 16;
            *(u32x4*)(dst + tile * 16 + 8 * c8) = o; }
        __syncthreads();
    }
}

typedef short bf16x8 __attribute__((ext_vector_type(8)));
typedef float f32x16 __attribute__((ext_vector_type(16)));
typedef float f32x2_t __attribute__((ext_vector_type(2)));
typedef __bf16 bf16x2_t __attribute__((ext_vector_type(2)));
DI unsigned cvtpk(float lo, float hi) { f32x2_t v = {lo, hi}; bf16x2_t b = __builtin_convertvector(v, bf16x2_t); return __builtin_bit_cast(unsigned, b); }
DI bf16x8 pack8(const f32x16& p, int s8) { u32x4 w; w.x = cvtpk(p[s8 + 0], p[s8 + 1]); w.y = cvtpk(p[s8 + 2], p[s8 + 3]); w.z = cvtpk(p[s8 + 4], p[s8 + 5]); w.w = cvtpk(p[s8 + 6], p[s8 + 7]); return __builtin_bit_cast(bf16x8, w); }
#define MFMA32(a, b, c) __builtin_amdgcn_mfma_f32_32x32x16_bf16((a), (b), (c), 0, 0, 0)
template <int DQK, bool NA, int EXPV = 0> DI void attn_unit(const bf16_t* proj, int pitch, int qcol, int kcol, const bf16_t* VT, bf16_t* H, int ocol, int q0, int t_lo, int t_hi, LAS unsigned char* lds, int tid, int wave, int lane,
                                             const float* rpb = nullptr, int nwin = 0, int krow0 = 0) {
    constexpr int KS = DQK * 2 + 16, KBUF = 64 * KS, VS = 144, VBUF = 64 * VS, CPR = DQK / 8, NDS = DQK / 16;
    LAS unsigned char* Kb = lds; LAS unsigned char* Vb = lds + 2 * KBUF;
    const int r32 = lane & 31, h = lane >> 5;
    const int k0r = tid / CPR, k0c = tid % CPR, k1r = (512 + tid) / CPR, k1c = (512 + tid) % CPR, vrow = tid >> 3, vc = tid & 7;
    const bool two = (DQK == 96) && tid < 256;
    bf16x8 qf[NDS];
    { const bf16_t* qp = proj + (size_t)(q0 + wave * 32 + r32) * pitch + qcol + 8 * h;
#pragma unroll
      for (int ds = 0; ds < NDS; ++ds) qf[ds] = *(const bf16x8*)(qp + 16 * ds); }
    f32x16 o0, o1, negm;
#pragma unroll
    for (int r = 0; r < 16; ++r) { o0[r] = 0.f; o1[r] = 0.f; negm[r] = 0.f; }
    float mhat = 0.f, l = 0.f;
    unsigned zz_ = 0u; asm volatile("" : "+v"(zz_)); u32x4 kr0, kr1 = (u32x4){zz_, zz_, zz_, zz_}, vr;
    LAS float* rpbs = (LAS float*)(lds + 2 * KBUF + 2 * VBUF);
    int na_r = 0, na_c = 0, na_rs = 0, na_cs = 0;
    if (NA) { if (tid < 465) rpbs[tid] = rpb[tid] * LOG2E; na_r = (q0 >> 6) + (wave >> 1); na_c = 32 * (wave & 1) + r32; na_rs = min(max(na_r - 4, 0), 248); na_cs = min(max(na_c - 8, 0), 48); }
#define AT_KV0(t) (NA ? ((t) < nwin ? (krow0 + (t)) * 64 : SEQ + ((t) - nwin) * 64) : (t) * 64)
#define AT_GLOAD(t) do { const int kv0_ = AT_KV0(t); kr0 = *(const u32x4*)(proj + (size_t)(kv0_ + k0r) * pitch + kcol + 8 * k0c); \
        if (two) kr1 = *(const u32x4*)(proj + (size_t)(kv0_ + k1r) * pitch + kcol + 8 * k1c); vr = *(const u32x4*)(VT + (size_t)vrow * MT + kv0_ + 8 * vc); } while (0)
#define AT_LSTORE(b) do { *(LAS u32x4*)(Kb + (b) * KBUF + k0r * KS + 16 * k0c) = kr0; if (two) *(LAS u32x4*)(Kb + (b) * KBUF + k1r * KS + 16 * k1c) = kr1; \
        *(LAS u32x4*)(Vb + (b) * VBUF + vrow * VS + 16 * vc) = vr; } while (0)
    AT_GLOAD(t_lo); AT_LSTORE(0); __syncthreads();
    if (t_lo + 1 < t_hi) AT_GLOAD(t_lo + 1);
    for (int t = t_lo; t < t_hi; ++t) {
        const int b = (t - t_lo) & 1;
        if (EXPV != 1 && t + 1 < t_hi) AT_LSTORE(b ^ 1);
        if (EXPV != 1 && t + 2 < t_hi) AT_GLOAD(t + 2);
        const int na_kr = krow0 + t;
        const bool active = !NA || t >= nwin || (na_kr >= na_rs && na_kr < na_rs + 8);
        if (active) {
        f32x16 p0, p1;
        bf16x8 vf0[4], vf1[4];
        { bf16x8 kf0[NDS], kf1[NDS];
          const LAS unsigned char* kb = Kb + b * KBUF + r32 * KS + 16 * h; const LAS unsigned char* vb = Vb + b * VBUF + r32 * VS + 16 * h;
#pragma unroll
          for (int ds = 0; ds < NDS; ++ds) { kf0[ds] = *(const LAS bf16x8*)(kb + 32 * ds); kf1[ds] = *(const LAS bf16x8*)(kb + 32 * KS + 32 * ds); }
          __builtin_amdgcn_sched_barrier(0);
#pragma unroll
          for (int ds = 0; ds < NDS; ++ds) {
              if (ds == 0) { p0 = MFMA32(kf0[0], qf[0], negm); p1 = MFMA32(kf1[0], qf[0], negm); } else { p0 = MFMA32(kf0[ds], qf[ds], p0); p1 = MFMA32(kf1[ds], qf[ds], p1); }
              if (ds < 4) { vf0[ds] = *(const LAS bf16x8*)(vb + 32 * ds); vf1[ds] = *(const LAS bf16x8*)(vb + 32 * VS + 32 * ds); }
              __builtin_amdgcn_sched_barrier(0); } }
        if (NA && t < nwin) { const LAS float* bp = rpbs + (na_kr - na_r + 7) * 31 + 15 - na_c;
#pragma unroll
            for (int r = 0; r < 16; ++r) { const int kc = (r & 3) + 8 * (r >> 2) + 4 * h;
                { const bool ok = kc >= na_cs && kc < na_cs + 16; p0[r] = ok ? p0[r] + bp[ok ? kc : na_c] : -1e30f; }
                { const int kc1 = kc + 32; const bool ok = kc1 >= na_cs && kc1 < na_cs + 16; p1[r] = ok ? p1[r] + bp[ok ? kc1 : na_c] : -1e30f; } } }
        float mt = 0.f;
        if (EXPV != 2) { mt = __builtin_fmaxf(__builtin_fmaxf(p0[0], p1[0]), p0[1]);
#pragma unroll
        for (int r = 1; r < 16; r += 1) mt = __builtin_fmaxf(__builtin_fmaxf(mt, p1[r]), r + 1 < 16 ? p0[r + 1] : p1[r]);
        mt = fmaxf(mt, SHX(mt, 32)); }
        if (EXPV != 2 && __any(mt > 8.0f)) {
            const float dlt = fmaxf(mt, 0.f), alpha = __builtin_amdgcn_exp2f(-dlt); mhat += dlt;
#pragma unroll
            for (int r = 0; r < 16; ++r) { p0[r] -= dlt; p1[r] -= dlt; negm[r] = -mhat; }
            l *= alpha; o0 = o0 * alpha; o1 = o1 * alpha;
        }
        float la = 0.f;
#pragma unroll
        for (int r = 0; r < 16; ++r) { if (EXPV != 2) { p0[r] = __builtin_amdgcn_exp2f(p0[r]); p1[r] = __builtin_amdgcn_exp2f(p1[r]); la += p0[r]; la += p1[r]; } }
        l += la;
        bf16x8 pb[4]; pb[0] = pack8(p0, 0); pb[1] = pack8(p0, 8); pb[2] = pack8(p1, 0); pb[3] = pack8(p1, 8);
#pragma unroll
        for (int ks = 0; ks < 4; ++ks) { o0 = MFMA32(vf0[ks], pb[ks], o0); o1 = MFMA32(vf1[ks], pb[ks], o1); }
        }
        __syncthreads();
    }
#undef AT_GLOAD
#undef AT_KV0
#undef AT_LSTORE
    l += SHX(l, 32); const float il = 1.0f / l;
    bf16_t* op = H + (size_t)(q0 + wave * 32 + r32) * DM + ocol + 4 * h;
#pragma unroll
    for (int g = 0; g < 4; ++g) {
        u32x2 w0; w0.x = cvtpk(o0[4 * g] * il, o0[4 * g + 1] * il); w0.y = cvtpk(o0[4 * g + 2] * il, o0[4 * g + 3] * il); *(u32x2*)(op + 8 * g) = w0;
        u32x2 w1; w1.x = cvtpk(o1[4 * g] * il, o1[4 * g + 1] * il); w1.y = cvtpk(o1[4 * g + 2] * il, o1[4 * g + 3] * il); *(u32x2*)(op + 32 + 8 * g) = w1; }
}
DI void phase_attn(const Params& P, LAS unsigned char* lds, int tid, int wave, int lane, bool second) {
    const bf16_t* proj = (const bf16_t*)(P.ws + WS_PROJAB); const bf16_t* VAT = (const bf16_t*)(P.ws + WS_VAT); const bf16_t* VBT = (const bf16_t*)(P.ws + WS_VBT);
    bf16_t* H = (bf16_t*)(P.ws + WS_H);
    for (int u = blockIdx.x; u < 1040; u += gridDim.x) {
        int hd, q0, t_lo;
        if (u < 1024) { const int i = u >> 8, r = u & 255, x = r & 7, j = r >> 3; hd = (i >> 1) * 8 + x; q0 = (j + 32 * (i & 1)) * 256; t_lo = 0; }
        else { hd = u - 1024; q0 = SEQ; t_lo = SEQ / 64; }
#ifdef ATTN_EXPV
        if (second) { bf16_t* Hd = (bf16_t*)(P.ws + WS_DUMMY);
            if (hd < 8) attn_unit<64, false, ATTN_EXPV>(proj, ABP, hd * 64, 512 + (hd >> 2) * 64, VAT + (size_t)(hd >> 2) * 64 * MT, Hd, hd * 64, q0 & 8191, t_lo, MT / 64, lds, tid, wave, lane);
            else { const int hb = hd - 8; attn_unit<96, false, ATTN_EXPV>(proj, ABP, 768 + hb * 96, ABIN + hb * 128, VBT + (size_t)hb * 64 * MT, Hd, 512 + hb * 64, q0 & 8191, t_lo, MT / 64, lds, tid, wave, lane); }
            continue; }
#endif
        if (hd < 8) attn_unit<64, false>(proj, ABP, hd * 64, 512 + (hd >> 2) * 64, VAT + (size_t)(hd >> 2) * 64 * MT, H, hd * 64, q0, t_lo, MT / 64, lds, tid, wave, lane);
        else { const int hb = hd - 8; attn_unit<96, false>(proj, ABP, 768 + hb * 96, ABIN + hb * 128, VBT + (size_t)hb * 64 * MT, H, 512 + hb * 64, q0, t_lo, MT / 64, lds, tid, wave, lane); }
    }
}

DI void phase_postCD(const Params& P, LAS unsigned char* lds, int tid, int wave, int lane, bool second) {
    bf16_t* proj = (bf16_t*)(P.ws + WS_PROJCD); bf16_t* VDT = (bf16_t*)(P.ws + WS_VDT);
    LAS bf16_t* vt = (LAS bf16_t*)lds; constexpr int VTS = 18;
    const float dqn = P.in[21][lane] * (0.125f * LOG2E), dkn = P.in[22][lane];
    for (int tile = blockIdx.x; tile < MT / 16; tile += gridDim.x) {
        for (int i = 0; i < 2; ++i) {
            const int tt = wave * 2 + i, m = tile * 16 + tt, pp = swap23(tt);
            bf16_t* raw = proj + (size_t)m * CDP; const bf16_t* rawi = raw; if (second) raw = (bf16_t*)(P.ws + WS_DUMMY) + (size_t)(m & 1023) * CDP;
            float xq[8], xk[8]; bf16_t rq[8], rk[8], xv[8];
#pragma unroll
            for (int hh = 0; hh < 8; ++hh) { rq[hh] = rawi[2560 + hh * 64 + lane]; rk[hh] = rawi[3072 + hh * 64 + lane]; xv[hh] = rawi[3584 + hh * 64 + lane]; }
            __builtin_amdgcn_sched_barrier(0);
#pragma unroll
            for (int hh = 0; hh < 8; ++hh) { xq[hh] = bf2f(rq[hh]); xk[hh] = bf2f(rk[hh]); }
#pragma unroll
            for (int hh = 0; hh < 8; ++hh) {
                { const float x = xq[hh]; const float ss = wave_sum(x * x, lane); raw[2560 + hh * 64 + lane] = f2bf(x * rsqrtf(ss * (1.f / 64.f) + EPS) * dqn); }
                { const float x = xk[hh]; const float ss = wave_sum(x * x, lane); raw[3072 + hh * 64 + lane] = f2bf(x * rsqrtf(ss * (1.f / 64.f) + EPS) * dkn); }
                vt[(hh * 64 + lane) * VTS + pp] = xv[hh]; }
        }
        __syncthreads();
        for (int c = tid; c < 512 * 2; c += 512) { const int row = c >> 1, c8 = c & 1; const LAS unsigned* s = (const LAS unsigned*)(vt + row * VTS + 8 * c8);
            u32x4 o; o.x = s[0]; o.y = s[1]; o.z = s[2]; o.w = s[3];
            bf16_t* dst = VDT + (size_t)row * MT + tile * 16; if (second) dst = (bf16_t*)(P.ws + WS_DUMMY + 8 * MiB) + (size_t)row * 1024 + (tile & 31) * 16;
            *(u32x4*)(dst + 8 * c8) = o; }
        __syncthreads();
    }
}
DI void phase_na(const Params& P, LAS unsigned char* lds, int tid, int wave, int lane) {
    const bf16_t* proj = (const bf16_t*)(P.ws + WS_PROJCD); const bf16_t* VDT = (const bf16_t*)(P.ws + WS_VDT); bf16_t* H = (bf16_t*)(P.ws + WS_H);
    for (int u = blockIdx.x; u < 512; u += gridDim.x) {
        const int hh = u & 7, r0 = (u >> 3) * 4;
        const int krow0 = min(max(r0 - 4, 0), 248), klast = min(max(r0 - 1, 0), 248) + 7, nwin = klast - krow0 + 1;
        attn_unit<64, true>(proj, CDP, 2560 + hh * 64, 3072 + hh * 64, VDT + (size_t)hh * 64 * MT, H, 512 + hh * 64, r0 * 64, 0, nwin + CTX / 64, lds, tid, wave, lane, P.in[23] + hh * 465, nwin, krow0);
    }
}
constexpr int HS = 144;
DI int hg_rowbase(int R) { return R < 256 ? R * 64 : SEQ + (R - 256) * 64; }
#define MFMA32(a, b, c) __builtin_amdgcn_mfma_f32_32x32x16_bf16((a), (b), (c), 0, 0, 0)
DI void hgrn_gates(const Params& P, const bf16_t* proj, int rowbase, int hh, int tid, LAS float* segtot, LAS float* gmids, float (&gc)[16], float (&kin)[16], float& gtot, float& gmid) {
    const int dir = tid >> 8, seg = (tid >> 6) & 3, k = tid & 63, ch = hh * 64 + k;
    const float b0 = P.in[19][dir * 512 + ch], b1 = P.in[19][1024 + dir * 512 + ch]; const float lb = 1.0f / (1.0f + __expf(b0 - b1));
    const bf16_t* zp = proj + (size_t)(rowbase + 16 * seg) * CDP + 512 + dir * 512 + ch;
    float g[16]; bf16_t rz[16];
#pragma unroll
    for (int j = 0; j < 16; ++j) rz[j] = zp[(size_t)j * CDP];
    __builtin_amdgcn_sched_barrier(0);
#pragma unroll
    for (int j = 0; j < 16; ++j) { const float z = bf2f(rz[j]); const float f = lb + (1.0f - lb) * sigmoidf_(z); g[j] = __logf(f); kin[j] = 1.0f - f; }
    if (dir == 0) { float a = 0.f;
#pragma unroll
        for (int j = 0; j < 16; ++j) { a += g[j]; gc[j] = a; } }
    else { float a = 0.f;
#pragma unroll
        for (int j = 15; j >= 0; --j) { a += g[j]; gc[j] = a; } }
    segtot[(dir * 4 + seg) * 64 + k] = dir == 0 ? gc[15] : gc[0];
    __syncthreads();
    float off = 0.f; gtot = 0.f;
#pragma unroll
    for (int s2 = 0; s2 < 4; ++s2) { const float v = segtot[(dir * 4 + s2) * 64 + k]; gtot += v; if (dir == 0 ? (s2 < seg) : (s2 > seg)) off += v; }
#pragma unroll
    for (int j = 0; j < 16; ++j) gc[j] += off;
    if (dir == 0 && seg == 1) gmids[k] = gc[15];
    if (dir == 1 && seg == 2) gmids[64 + k] = gc[0];
    __syncthreads();
    gmid = gmids[dir * 64 + k];
}
DI void phase_hgrn1(const Params& P, LAS unsigned char* lds, int tid, int wave, int lane) {
    const bf16_t* proj = (const bf16_t*)(P.ws + WS_PROJCD); float* HG = (float*)(P.ws + WS_HG); float* HGD = (float*)(P.ws + WS_HGD);
    LAS unsigned char* KdT = lds; LAS unsigned char* VTl = lds + 2 * 64 * HS; LAS float* segtot = (LAS float*)(lds + 3 * 64 * HS); LAS float* gmids = segtot + 512;
    const int r32 = lane & 31, h = lane >> 5;
    for (int it = blockIdx.x; it < 260 * 8; it += gridDim.x) {
        const int R = it >> 3, hh = it & 7, rowbase = hg_rowbase(R);
        float gc[16], kin[16], gtot, gmid;
        const u32x4 vw = *(const u32x4*)(proj + (size_t)(rowbase + (tid >> 3)) * CDP + 1536 + hh * 64 + (tid & 7) * 8);
        hgrn_gates(P, proj, rowbase, hh, tid, segtot, gmids, gc, kin, gtot, gmid);
        const int dir = tid >> 8, seg = (tid >> 6) & 3, k = tid & 63;
        { u32x4 w0, w1; float e[16];
#pragma unroll
          for (int j = 0; j < 16; ++j) e[j] = kin[j] * __expf(gtot - gc[j]);
          w0.x = pk2(e[0], e[1]); w0.y = pk2(e[2], e[3]); w0.z = pk2(e[4], e[5]); w0.w = pk2(e[6], e[7]); w1.x = pk2(e[8], e[9]); w1.y = pk2(e[10], e[11]); w1.z = pk2(e[12], e[13]); w1.w = pk2(e[14], e[15]);
          LAS unsigned char* dst = KdT + (dir * 64 + k) * HS + 32 * seg; *(LAS u32x4*)dst = w0; *(LAS u32x4*)(dst + 16) = w1; }
        { const int s = tid >> 3, v8 = (tid & 7) * 8; const u32x4 w = vw;
          const unsigned ww[4] = {w.x, w.y, w.z, w.w};
#pragma unroll
          for (int i = 0; i < 8; ++i) *(LAS bf16_t*)(VTl + (v8 + i) * HS + 2 * s) = (bf16_t)((ww[i >> 1] >> ((i & 1) * 16)) & 0xffffu); }
        const size_t idx = (size_t)(R * 8 + hh) * 2;
        if (seg == 0) HGD[(idx + dir) * 64 + k] = __expf(gtot);
        __syncthreads();
        { const int d = wave >> 2, vb = (wave >> 1) & 1, kb = wave & 1;
          f32x16 acc;
#pragma unroll
          for (int r = 0; r < 16; ++r) acc[r] = 0.f;
          const LAS unsigned char* ap = VTl + (32 * vb + r32) * HS + 16 * h; const LAS unsigned char* bp = KdT + (d * 64 + 32 * kb + r32) * HS + 16 * h;
#pragma unroll
          for (int ss = 0; ss < 4; ++ss) acc = MFMA32(*(const LAS bf16x8*)(ap + 32 * ss), *(const LAS bf16x8*)(bp + 32 * ss), acc);
          float* out = HG + (idx + d) * 4096 + 32 * kb + r32;
#pragma unroll
          for (int r = 0; r < 16; ++r) out[(size_t)(32 * vb + (r & 3) + 8 * (r >> 2) + 4 * h) * 64] = acc[r]; }
        __syncthreads();
    }
}
DI void phase_hgrn2(const Params& P, int tid, bool second) {
    float* HG = (float*)(P.ws + WS_HG); float* HGo = second ? (float*)(P.ws + WS_DUMMY) : HG; const float* HGD = (const float*)(P.ws + WS_HGD);
    for (int e = blockIdx.x * 512 + tid; e < 65536; e += gridDim.x * 512) {
        const int hh = e >> 13, dir = (e >> 12) & 1, vk = e & 4095, k = e & 63;
        float S = 0.f;
        for (int i0 = 0; i0 < 260; i0 += 13) {
            float Lc[13], Dc[13];
#pragma unroll
            for (int j = 0; j < 13; ++j) { const int i = i0 + j; const int R = dir == 0 ? (i < 4 ? 256 + i : i - 4) : 259 - i; const size_t idx = (size_t)(R * 8 + hh) * 2 + dir;
                Lc[j] = HG[idx * 4096 + vk]; Dc[j] = HGD[idx * 64 + k]; }
            __builtin_amdgcn_sched_barrier(0);
#pragma unroll
            for (int j = 0; j < 13; ++j) { const int i = i0 + j; const int R = dir == 0 ? (i < 4 ? 256 + i : i - 4) : 259 - i; const size_t idx = (size_t)(R * 8 + hh) * 2 + dir;
                HGo[(second ? (idx & 255) : idx) * 4096 + vk] = S; S = Dc[j] * S + Lc[j]; }
        }
    }
}
DI void phase_hgrn3(const Params& P, LAS unsigned char* lds, int tid, int wave, int lane) {
    const bf16_t* proj = (const bf16_t*)(P.ws + WS_PROJCD); const float* HG = (const float*)(P.ws + WS_HG); bf16_t* H = (bf16_t*)(P.ws + WS_H);
    constexpr int MB = 64 * HS;
    LAS unsigned char* Qg = lds; LAS unsigned char* Kg = lds + 2 * MB; LAS unsigned char* Sg = lds + 4 * MB; LAS unsigned char* VTl = lds + 6 * MB;
    LAS float* Os = (LAS float*)(lds + 7 * MB); LAS float* segtot = Os + 64 * 65; LAS float* gmids = segtot + 512;
    const int r32 = lane & 31, h = lane >> 5;
    for (int it = blockIdx.x; it < 256 * 8; it += gridDim.x) {
        const int R = it >> 3, hh = it & 7, rowbase = R * 64;
        float gc[16], kin[16], gtot, gmid;
        bf16_t rqv[16];
        { const int seg_ = (tid >> 6) & 3, k_ = tid & 63;
#pragma unroll
          for (int j = 0; j < 16; ++j) rqv[j] = proj[(size_t)(rowbase + 16 * seg_ + j) * CDP + hh * 64 + k_]; }
        const u32x4 vw = *(const u32x4*)(proj + (size_t)(rowbase + (tid >> 3)) * CDP + 1536 + hh * 64 + (tid & 7) * 8);
        const u32x4 gw = *(const u32x4*)(proj + (size_t)(rowbase + (tid >> 3)) * CDP + 2048 + hh * 64 + (tid & 7) * 8);
        f32x4 sa[2], sb[2];
#pragma unroll
        for (int d = 0; d < 2; ++d) { const float* sp = HG + ((size_t)(R * 8 + hh) * 2 + d) * 4096 + (tid >> 3) * 64 + (tid & 7) * 8; sa[d] = *(const f32x4*)sp; sb[d] = *(const f32x4*)(sp + 4); }
        hgrn_gates(P, proj, rowbase, hh, tid, segtot, gmids, gc, kin, gtot, gmid);
        const int dir = tid >> 8, seg = (tid >> 6) & 3, k = tid & 63;
#pragma unroll
        for (int j = 0; j < 16; ++j) { const int t = 16 * seg + j; const float q = silu(bf2f(rqv[j]));
            *(LAS bf16_t*)(Qg + (dir * 64 + t) * HS + 2 * k) = f2bf(q * __expf(fminf(gc[j] - gmid, 80.f)));
            *(LAS bf16_t*)(Kg + (dir * 64 + t) * HS + 2 * k) = f2bf(kin[j] * __expf(fminf(gmid - gc[j], 80.f))); }
        { const int s = tid >> 3, v8 = (tid & 7) * 8; const u32x4 w = vw;
          const unsigned ww[4] = {w.x, w.y, w.z, w.w}; const int sp = swap23(s);
#pragma unroll
          for (int i = 0; i < 8; ++i) *(LAS bf16_t*)(VTl + (v8 + i) * HS + 2 * sp) = (bf16_t)((ww[i >> 1] >> ((i & 1) * 16)) & 0xffffu); }
#pragma unroll
        for (int d = 0; d < 2; ++d) { const int v = tid >> 3, k8 = (tid & 7) * 8;
            const f32x4 a = sa[d], b = sb[d]; const LAS float* gm = gmids + d * 64 + k8;
            u32x4 w; w.x = pk2(a.x * __expf(gm[0]), a.y * __expf(gm[1])); w.y = pk2(a.z * __expf(gm[2]), a.w * __expf(gm[3])); w.z = pk2(b.x * __expf(gm[4]), b.y * __expf(gm[5])); w.w = pk2(b.z * __expf(gm[6]), b.w * __expf(gm[7]));
            *(LAS u32x4*)(Sg + (d * 64 + v) * HS + 2 * k8) = w; }
        __syncthreads();
        const int wd = wave >> 2, tb = (wave >> 1) & 1, vb = wave & 1;
        f32x16 acc;
        { f32x16 p0, p1;
#pragma unroll
          for (int r = 0; r < 16; ++r) { p0[r] = 0.f; p1[r] = 0.f; acc[r] = 0.f; }
          const LAS unsigned char* kp = Kg + (wd * 64 + r32) * HS + 16 * h; const LAS unsigned char* qp = Qg + (wd * 64 + 32 * tb + r32) * HS + 16 * h;
          bf16x8 qf[4];
#pragma unroll
          for (int ks = 0; ks < 4; ++ks) qf[ks] = *(const LAS bf16x8*)(qp + 32 * ks);
#pragma unroll
          for (int ks = 0; ks < 4; ++ks) { p0 = MFMA32(*(const LAS bf16x8*)(kp + 32 * ks), qf[ks], p0); p1 = MFMA32(*(const LAS bf16x8*)(kp + 32 * HS + 32 * ks), qf[ks], p1); }
          const int t = 32 * tb + r32;
#pragma unroll
          for (int r = 0; r < 16; ++r) { const int s0 = (r & 3) + 8 * (r >> 2) + 4 * h, s1 = s0 + 32;
              const bool ok0 = wd == 0 ? (s0 <= t) : (s0 >= t), ok1 = wd == 0 ? (s1 <= t) : (s1 >= t); p0[r] = ok0 ? p0[r] : 0.f; p1[r] = ok1 ? p1[r] : 0.f; }
          bf16x8 pb[4]; pb[0] = pack8(p0, 0); pb[1] = pack8(p0, 8); pb[2] = pack8(p1, 0); pb[3] = pack8(p1, 8);
          const LAS unsigned char* vp = VTl + (32 * vb + r32) * HS + 16 * h; const LAS unsigned char* sp = Sg + (wd * 64 + 32 * vb + r32) * HS + 16 * h;
#pragma unroll
          for (int ks = 0; ks < 4; ++ks) { acc = MFMA32(*(const LAS bf16x8*)(vp + 32 * ks), pb[ks], acc); acc = MFMA32(*(const LAS bf16x8*)(sp + 32 * ks), qf[ks], acc); } }
        { const int t = 32 * tb + r32;
          if (wd == 0) {
#pragma unroll
              for (int r = 0; r < 16; ++r) Os[t * 65 + 32 * vb + (r & 3) + 8 * (r >> 2) + 4 * h] = acc[r]; }
          __syncthreads();
          if (wd == 1) {
#pragma unroll
              for (int r = 0; r < 16; ++r) Os[t * 65 + 32 * vb + (r & 3) + 8 * (r >> 2) + 4 * h] += acc[r]; }
          __syncthreads(); }
        { const int t = tid >> 3, v8 = (tid & 7) * 8; float o[8]; float ss = 0.f;
#pragma unroll
          for (int i = 0; i < 8; ++i) { o[i] = Os[t * 65 + v8 + i]; ss += o[i] * o[i]; }
          ss += SHX(ss, 1); ss += SHX(ss, 2); ss += SHX(ss, 4);
          const float rs = rsqrtf(ss * (1.f / 64.f) + EPS);
          const unsigned gg[4] = {gw.x, gw.y, gw.z, gw.w};
          float y[8];
#pragma unroll
          for (int i = 0; i < 8; ++i) { const float gate = __uint_as_float(((gg[i >> 1] >> ((i & 1) * 16)) & 0xffffu) << 16); y[i] = o[i] * rs * P.in[20][v8 + i] * silu(gate); }
          u32x4 w; w.x = pk2(y[0], y[1]); w.y = pk2(y[2], y[3]); w.z = pk2(y[4], y[5]); w.w = pk2(y[6], y[7]);
          *(u32x4*)(H + (size_t)(rowbase + t) * DM + hh * 64 + v8) = w; }
        __syncthreads();
    }
}

DI void gemm_up(const Params& P, LAS unsigned char* lds, int slot, int M, int tid) {
    pg8::Gemm g{(const bf16_t*)(P.ws + WS_H), (const bf16_t*)(P.ws + WS_FFN0 + slot * FFN_SLOT), M, 2 * FF, DM, DM};
    pg8::StaticOrder S; S.init(M, 2 * FF, gridDim.x, blockIdx.x);
    pg8::EpiSwiglu E{(bf16_t*)(P.ws + WS_U), FF};
    pg8::gemm_phase<pg8::EpiSwiglu, pg8::StaticOrder, true, true>(lds, g, S, E, tid);
}
DI void gemm_res(const Params& P, LAS unsigned char* lds, const bf16_t* A, const bf16_t* Bt, int M, int K, bool first, const float* coefL, const float* coefC, float mult, int tid) {
    float* xc = (float*)(P.ws + WS_XC);
    {
        pg8::Gemm g{A, Bt, SEQ, DM, K, K};
        pg8::StaticOrder S; S.init(SEQ, DM, gridDim.x, blockIdx.x);
        pg8::EpiResidual E{first ? P.in[0] : (const float*)P.out, nullptr, P.out, nullptr, coefL, nullptr, mult};
        pg8::gemm_phase<pg8::EpiResidual, pg8::StaticOrder, true, true>(lds, g, S, E, tid);
    }
    if (M > SEQ) {
        const int nsplit = K / 256, c = blockIdx.x, ks = c >> 2;
        pg8::Gemm g{A + (size_t)SEQ * K + ks * 256, Bt + ks * 256, CTX, DM, 256, K};
        pg8::OneUnitOrder S{c, 4 * nsplit};
        pg8::EpiPartCtx E{(float*)(P.ws + WS_PART) + (size_t)ks * CTX * DM, coefC, mult};
        pg8::gemm_phase<pg8::EpiPartCtx, pg8::OneUnitOrder, true, true>(lds, g, S, E, tid);
    }
}
DI void gemm_store(const Params& P, LAS unsigned char* lds, const bf16_t* Bt, int N, bf16_t* O, int tid) {
    pg8::Gemm g{(const bf16_t*)(P.ws + WS_H), Bt, MT, N, DM, DM};
    pg8::StaticOrder S; S.init(MT, N, gridDim.x, blockIdx.x);
    pg8::EpiStoreBf16 E{O, N};
    pg8::gemm_phase<pg8::EpiStoreBf16, pg8::StaticOrder, true, true>(lds, g, S, E, tid);
}
#define XB_TMO      128
#define XB_XCNT(j)  (256  + 64 * (j))
#define XB_XSUB(j)  (1280 + 64 * (j))
#define XB_XGEN(j)  (2304 + 64 * (j))
#define XB_TOP      3328
#define XB_TOPGEN   3392
#define XCD_BAR_WORDS 3456
#define XB_SPIN_CAP (1u << 18)

__device__ __forceinline__ unsigned xb_ld(unsigned* p)              { return __hip_atomic_load(p, __ATOMIC_RELAXED, __HIP_MEMORY_SCOPE_AGENT); }
__device__ __forceinline__ unsigned xb_add(unsigned* p, unsigned v) { return __hip_atomic_fetch_add(p, v, __ATOMIC_RELAXED, __HIP_MEMORY_SCOPE_AGENT); }
__device__ __forceinline__ unsigned xb_xcc_id() { return (unsigned)__builtin_amdgcn_s_getreg((3 << 11) | 20) & 0xFu; }
#define XB_SPIN(cond, bar) do { unsigned _sp = 0; while (cond) { __builtin_amdgcn_s_sleep(1); \
    if ((++_sp & 255u) == 0u) { if (xb_ld(&(bar)[XB_TMO])) break; if (_sp > XB_SPIN_CAP) { atomicAdd(&(bar)[XB_TMO], 1u); break; } } } } while (0)

struct XcdBarrier {
    unsigned* bar; unsigned x;
    volatile LAS unsigned* st;
};

__device__ __forceinline__ XcdBarrier xcd_barrier_post(unsigned* bar, volatile LAS unsigned* st) {
    XcdBarrier b; b.bar = bar; b.x = xb_xcc_id(); b.st = st;
    if (threadIdx.x == 0) (void)xb_add(&bar[XB_XCNT(b.x)], 1u);
    return b;
}
__device__ __forceinline__ void xcd_barrier_complete(unsigned* bar, unsigned x, unsigned& nloc, unsigned& nx) {
    const unsigned G = gridDim.x * gridDim.y * gridDim.z;
    unsigned sum, cnt, mine, sp = 0u;
    for (;;) {
        sum = 0u; cnt = 0u; mine = 0u;
#pragma unroll
        for (unsigned j = 0; j < 16; ++j) { const unsigned c = xb_ld(&bar[XB_XCNT(j)]); sum += c; cnt += (c > 0u) ? 1u : 0u; mine = (j == x) ? c : mine; }
        if (sum == G) break;
        __builtin_amdgcn_s_sleep(1);
        if ((++sp & 255u) == 0u) { if (xb_ld(&bar[XB_TMO])) break; if (sp > XB_SPIN_CAP) { atomicAdd(&bar[XB_TMO], 1u); break; } }
    }
    nloc = mine > 0u ? mine : 1u; nx = cnt > 0u ? cnt : 1u;
}

__device__ __forceinline__ void xcd_barrier(const XcdBarrier& b) {
    asm volatile("s_waitcnt vmcnt(0)" ::: "memory");
    __syncthreads();
    if (threadIdx.x == 0) {
        unsigned* bar = b.bar;
        __builtin_amdgcn_s_waitcnt(0);
        unsigned nloc = b.st[0], nx = b.st[1];
        if (nloc == 0u) { xcd_barrier_complete(bar, b.x, nloc, nx); b.st[0] = nloc; b.st[1] = nx; }
        const unsigned old = xb_add(&bar[XB_XSUB(b.x)], 1u);
        const unsigned gen = old / nloc;
        if (old + 1u == (gen + 1u) * nloc) {
            __builtin_amdgcn_fence(__ATOMIC_RELEASE, "agent");
            asm volatile("s_waitcnt vmcnt(0)" ::: "memory");
            const unsigned og = xb_add(&bar[XB_TOP], 1u);
            const unsigned tg = og / nx;
            if (og + 1u == (tg + 1u) * nx) xb_add(&bar[XB_TOPGEN], 1u);
            else XB_SPIN(xb_ld(&bar[XB_TOPGEN]) == tg, bar);
            __builtin_amdgcn_fence(__ATOMIC_ACQUIRE, "agent");
            xb_add(&bar[XB_XGEN(b.x)], 1u);
            asm volatile("s_waitcnt vmcnt(0)" ::: "memory");
        } else {
            XB_SPIN(xb_ld(&bar[XB_XGEN(b.x)]) == gen, bar);
            __builtin_amdgcn_fence(__ATOMIC_ACQUIRE, "agent");
            asm volatile("s_waitcnt vmcnt(0)" ::: "memory");
        }
    }
    __syncthreads();
}

enum { K_PRO = 0, K_NORM, K_UP, K_RES, K_STORE, K_POSTAB, K_ATTN, K_POSTCD, K_MIX1, K_MIX2 };
__global__ void __launch_bounds__(512, 2) mega(Params P0) {
    extern __shared__ __attribute__((aligned(16))) unsigned char lds_raw[];
    LAS unsigned char* lds = (LAS unsigned char*)lds_raw;
    cg::grid_group grid = cg::this_grid();
    const int wave_s = __builtin_amdgcn_readfirstlane(threadIdx.x >> 6);
    volatile LAS unsigned* barst = (volatile LAS unsigned*)(lds + LDS_BARST);
    if (threadIdx.x < 2) barst[threadIdx.x] = 0u;
    __syncthreads();
    (void)xcd_barrier_post((unsigned*)(P0.ws + WS_BAR), barst);
    for (int step = P0.ph_lo; step < P0.ph_hi; ++step) {
        Params P = P0;
        { __attribute__((address_space(1))) unsigned char* g_ = (__attribute__((address_space(1))) unsigned char*)P0.ws; asm volatile("" : "+s"(g_)); P.ws = (unsigned char*)g_; }
        { __attribute__((address_space(1))) float* g_ = (__attribute__((address_space(1))) float*)P0.out; asm volatile("" : "+s"(g_)); P.out = (float*)g_; }
#pragma unroll
        for (int i_ = 0; i_ < 25; ++i_) { const __attribute__((address_space(1))) float* g_ = (const __attribute__((address_space(1))) float*)P0.in[i_]; asm volatile("" : "+s"(g_)); P.in[i_] = (const float*)g_; }
#ifdef DUP_PH
        const int ph = step <= DUP_PH ? step : step - 1;
        const bool second = step == DUP_PH + 1;
#else
        const int ph = step; const bool second = false;
#endif
        int lane; asm volatile("v_mbcnt_lo_u32_b32 %0, -1, 0\n\tv_mbcnt_hi_u32_b32 %0, -1, %0" : "=v"(lane));
        const int wave = wave_s, tid = wave * 64 + lane;
        const float* modx = (const float*)(P.ws + WS_MODX); const float* modc = (const float*)(P.ws + WS_MODC);
        const int l = ph >= 12 ? 1 : 0;
        const int M = ph >= 20 ? SEQ : MT;
        int kind;
        switch (ph) {
        case 0: kind = K_PRO; break;
        case 1: case 4: case 9: case 12: case 15: case 21: kind = K_NORM; break;
        case 2: case 10: case 13: case 22: kind = K_UP; break;
        case 3: case 8: case 11: case 14: case 20: case 23: kind = K_RES; break;
        case 5: case 16: kind = K_STORE; break;
        case 6: kind = K_POSTAB; break;
        case 7: kind = K_ATTN; break;
        case 17: kind = K_POSTCD; break;
        case 18: kind = K_MIX1; break;
        default: kind = K_MIX2; break;
        }
        if (kind == K_PRO) phase_prologue(P, lds, tid, wave, lane, second);
        else if (kind == K_NORM) {
            const int idx = (ph == 1 || ph == 12) ? 0 : ((ph == 4 || ph == 15) ? 1 : 2);
            phase_normmod(P, l, idx, ph == 1, M, (ph == 1 || ph == 21) ? 0 : (ph == 9 ? 4 : 11), wave, lane);
            if (ph == 4 || ph == 21) { LAS float* scr = (LAS float*)(lds + wave * 16384); const int j = ph == 4 ? 0 : 1;
                for (int it = blockIdx.x * 8 + wave; it < FFN_ITEMS; it += gridDim.x * 8) convert_ffn_item(P, 1, j, j, it, scr, lane); }
        }
        else if (kind == K_UP) gemm_up(P, lds, (ph == 10 || ph == 22) ? 1 : 0, M, tid);
        else if (kind == K_RES) {
            const bool ffn = !(ph == 8 || ph == 20); const int slot = (ph == 11 || ph == 23) ? 1 : 0; const int ci = ffn ? (slot ? 8 : 2) : 5;
            const bf16_t* A = ffn ? (const bf16_t*)(P.ws + WS_U) : (const bf16_t*)(P.ws + WS_H);
            const bf16_t* Bt = ffn ? (const bf16_t*)(P.ws + WS_FFN0 + slot * FFN_SLOT + FFN_W2OFF) : (const bf16_t*)(P.ws + (ph == 8 ? WS_WOUTAB : WS_WOUTCD));
            gemm_res(P, lds, A, Bt, M, ffn ? FF : DM, ph == 3, modx + l * 9216 + ci * DM, modc + l * 9216 + ci * DM, ffn ? 0.5f : 1.0f, tid);
        }
        else if (kind == K_STORE) { if (ph == 5) gemm_store(P, lds, (const bf16_t*)(P.ws + WS_WINAB), ABP, (bf16_t*)(P.ws + WS_PROJAB), tid);
                                    else gemm_store(P, lds, (const bf16_t*)(P.ws + WS_WINCD), CDP, (bf16_t*)(P.ws + WS_PROJCD), tid); }
        else if (kind == K_POSTAB) phase_postAB(P, lds, tid, wave, lane, second);
        else if (kind == K_ATTN) phase_attn(P, lds, tid, wave, lane, second);
        else if (kind == K_POSTCD) {
#ifdef PROBE_ALT
            phase_postCD(P, lds, tid, wave, lane, second); if (!second) phase_hgrn1(P, lds, tid, wave, lane);
#else
            if (!second) phase_postCD(P, lds, tid, wave, lane, false); phase_hgrn1(P, lds, tid, wave, lane);
#endif
        }
        else if (kind == K_MIX1) {
#ifdef PROBE_ALT
            phase_hgrn2(P, tid, second); if (!second) phase_na(P, lds, tid, wave, lane);
#else
            if (!second) phase_hgrn2(P, tid, false); phase_na(P, lds, tid, wave, lane);
#endif
        }
        else phase_hgrn3(P, lds, tid, wave, lane);
        if (step + 1 < P.ph_hi) { if (P0.ph_hi < 0) grid.sync();   { XcdBarrier xb_; xb_.bar = (unsigned*)(P.ws + WS_BAR); xb_.x = xb_xcc_id(); xb_.st = (volatile LAS unsigned*)(lds + LDS_BARST); xcd_barrier(xb_); } }
    }
}

extern "C" void kernel_launch(void* const* d_in, const int* in_sizes, int n_in, void* d_out, int out_size, void* d_ws, size_t ws_size, hipStream_t stream) {
    static int grid = 0;
    if (grid == 0) {
        if (n_in != 25 || out_size != SEQ * DM || ws_size < WS_END) { fprintf(stderr, "kernel_launch: unexpected shapes n_in %d out %d ws %zu\n", n_in, out_size, ws_size); grid = -1; return; }
        int dev = 0, cus = 0, per_cu = 0;
        hipGetDevice(&dev); hipDeviceGetAttribute(&cus, hipDeviceAttributeMultiprocessorCount, dev);
        if (hipFuncSetAttribute((const void*)mega, hipFuncAttributeMaxDynamicSharedMemorySize, LDS_BYTES) != hipSuccess) { fprintf(stderr, "hipFuncSetAttribute failed\n"); grid = -1; return; }
        hipOccupancyMaxActiveBlocksPerMultiprocessor(&per_cu, (const void*)mega, 512, LDS_BYTES);
        if (per_cu < 1) { fprintf(stderr, "occupancy query says %d\n", per_cu); per_cu = 1; }
        (void)hipGetLastError();
        grid = cus;
    }
    if (grid < 0) return;
    hipMemsetAsync((char*)d_ws, 0, CTL_ZERO_BYTES, stream);
    Params p{};
    for (int i = 0; i < 25; ++i) p.in[i] = (const float*)d_in[i];
    p.out = (float*)d_out; p.ws = (unsigned char*)d_ws;
#if N_LAUNCH_MODE == 1
    for (int ph = 0; ph < NPH; ++ph) { p.ph_lo = ph; p.ph_hi = ph + 1; hipLaunchKernelGGL(mega, dim3(grid), dim3(512), LDS_BYTES, stream, p); }
#else
    p.ph_lo = 0; p.ph_hi = NPH;
    void* args[] = {&p};
    hipError_t e = hipLaunchCooperativeKernel((const void*)mega, dim3(grid), dim3(512), args, LDS_BYTES, stream);
    if (e != hipSuccess) fprintf(stderr, "cooperative launch failed: %s (grid %d)\n", hipGetErrorString(e), grid);
#endif
}
```

```cpp
#include <hip/hip_runtime.h>
#include <hip/hip_cooperative_groups.h>
#include <cstdio>
#include <cstdint>
namespace cg = cooperative_groups;
#ifndef NAIVE_ATTN
#define NAIVE_ATTN 0
#endif
#ifndef NAIVE_MIX
#define NAIVE_MIX 0
#endif
#ifndef N_LAUNCH_MODE
#define N_LAUNCH_MODE 0
#endif
namespace pg8 {
#define PG8_LAS __attribute__((address_space(3)))
typedef unsigned short bf16_t;
typedef short bf16x8 __attribute__((ext_vector_type(8)));
typedef float f32x4 __attribute__((ext_vector_type(4)));
typedef unsigned u32x4 __attribute__((ext_vector_type(4)));
typedef unsigned u32x2 __attribute__((ext_vector_type(2)));
constexpr int BM = 256, BK = 64, HALF = 128, HTB = HALF * BK * 2, STAGE_BYTES = 8 * HTB, NXCD = 8, WGM = 8;
__host__ __device__ __forceinline__ int lds_byte(int r, int c) { const int st = (r >> 4) * 2 + (c >> 5), rr = r & 15, cc = c & 31, ob = rr * 64 + cc * 2; return st * 1024 + (ob ^ (((ob >> 9) & 1) << 5)); }
__host__ __device__ __forceinline__ void stage_rc(int b, int& R, int& C) { const int st = b / 1024, sb = b % 1024, swz = sb ^ (((sb >> 9) & 1) << 5); R = (st >> 1) * 16 + swz / 64; C = (st & 1) * 32 + (swz % 64) / 2; }
__host__ __device__ __forceinline__ int perm32(int rho) { const int n = rho >> 4, i = rho & 15; return 8 * (i >> 2) + 4 * n + (i & 3); }
struct Unit { int pm, pn; };
struct Gemm { const bf16_t* A; const bf16_t* Bt; int M, N, K, ld; };
struct StaticOrder {
    int nM, nN, nwg, G, c;
    __host__ __device__ void init(int M, int N, int G_, int c_) { nM = M / BM; nN = N / BM; nwg = nM * nN; G = G_; c = c_; }
    __host__ __device__ bool next(int i, Unit& u) const {
        const long L = (long)i * G + c; if (L >= nwg) return false;
        int wgid = (int)L; { const int q = nwg / NXCD, r = nwg % NXCD, xcd = wgid % NXCD, off = wgid / NXCD; wgid = (xcd < r ? xcd * (q + 1) : r * (q + 1) + (xcd - r) * q) + off; }
        const int nig = WGM * nN, gid = wgid / nig, fm = gid * WGM, gsz = (nM - fm) < WGM ? (nM - fm) : WGM;
        u.pm = fm + ((wgid % nig) % gsz); u.pn = (wgid % nig) / gsz; return true;
    }
    __device__ __forceinline__ void a_ready(const Unit&) const {}
    __device__ __forceinline__ void done(const Unit&) const {}
};
__device__ __forceinline__ unsigned cvt_pk_bf16(float lo, float hi) { unsigned r; asm volatile("v_cvt_pk_bf16_f32 %0, %1, %2" : "=v"(r) : "v"(lo), "v"(hi)); return r; }
__device__ __forceinline__ float silu_f(float x) { return x * __builtin_amdgcn_rcpf(1.0f + __expf(-x)); }

struct EpiSwiglu {
    static constexpr bool PERM = true, AFTER_DRAIN = false;
    bf16_t* U; int ldu;
    __device__ __forceinline__ void operator()(const f32x4 (&acc)[2][2][4][2], const Unit& u, int wr, int wc, int fr, int fq) const {
        const int row0 = u.pm * BM + wr * 64 + fr, ff0 = u.pn * 128 + wc * 32 + 8 * fq;
#pragma unroll
        for (int ai = 0; ai < 2; ++ai)
#pragma unroll
            for (int m = 0; m < 4; ++m) { bf16_t* rowp = U + (size_t)(row0 + ai * HALF + m * 16) * ldu + ff0;
                const f32x4 a0 = acc[ai][0][m][0], a1 = acc[ai][0][m][1], b0 = acc[ai][1][m][0], b1 = acc[ai][1][m][1];
                u32x4 w; w.x = cvt_pk_bf16(silu_f(a0[0]) * b0[0], silu_f(a0[1]) * b0[1]); w.y = cvt_pk_bf16(silu_f(a0[2]) * b0[2], silu_f(a0[3]) * b0[3]);
                w.z = cvt_pk_bf16(silu_f(a1[0]) * b1[0], silu_f(a1[1]) * b1[1]); w.w = cvt_pk_bf16(silu_f(a1[2]) * b1[2], silu_f(a1[3]) * b1[3]);
                *(u32x4*)rowp = w; }
    }
};
struct EpiResidual {
    static constexpr bool PERM = true, AFTER_DRAIN = false;
    const float* baseL; const float* baseC; float* outL; float* outC; const float* coefL; const float* coefC; float mult;
    __device__ __forceinline__ void operator()(const f32x4 (&acc)[2][2][4][2], const Unit& u, int wr, int wc, int fr, int fq) const {
        const bool isC = u.pm >= 64;
        const float* base = isC ? baseC : baseL; float* out = isC ? outC : outL; const float* coef = isC ? coefC : coefL;
        const int row0 = (isC ? (u.pm - 64) : u.pm) * BM + wr * 64 + fr, col0 = u.pn * BM + wc * 32 + 8 * fq;
        f32x4 cf[2][2];
#pragma unroll
        for (int bj = 0; bj < 2; ++bj)
#pragma unroll
            for (int n = 0; n < 2; ++n) cf[bj][n] = *(const f32x4*)(coef + col0 + bj * HALF + 4 * n) * mult;
#pragma unroll
        for (int ai = 0; ai < 2; ++ai)
#pragma unroll
            for (int m = 0; m < 4; ++m) { const size_t off = (size_t)(row0 + ai * HALF + m * 16) * 1024 + col0;
#pragma unroll
                for (int bj = 0; bj < 2; ++bj)
#pragma unroll
                    for (int n = 0; n < 2; ++n) { const f32x4 b = *(const f32x4*)(base + off + bj * HALF + 4 * n);
                        *(f32x4*)(out + off + bj * HALF + 4 * n) = b + cf[bj][n] * acc[ai][bj][m][n]; } }
    }
};
struct EpiPartCtx {
    static constexpr bool PERM = true, AFTER_DRAIN = false;
    float* part; const float* coef; float mult;
    __device__ __forceinline__ void operator()(const f32x4 (&acc)[2][2][4][2], const Unit& u, int wr, int wc, int fr, int fq) const {
        const int row0 = wr * 64 + fr, col0 = u.pn * BM + wc * 32 + 8 * fq;
        f32x4 cf[2][2];
#pragma unroll
        for (int bj = 0; bj < 2; ++bj)
#pragma unroll
            for (int n = 0; n < 2; ++n) cf[bj][n] = *(const f32x4*)(coef + col0 + bj * HALF + 4 * n) * mult;
#pragma unroll
        for (int ai = 0; ai < 2; ++ai)
#pragma unroll
            for (int m = 0; m < 4; ++m) { float* rp = part + (size_t)(row0 + ai * HALF + m * 16) * 1024 + col0;
#pragma unroll
                for (int bj = 0; bj < 2; ++bj)
#pragma unroll
                    for (int n = 0; n < 2; ++n) *(f32x4*)(rp + bj * HALF + 4 * n) = cf[bj][n] * acc[ai][bj][m][n]; }
    }
};
struct OneUnitOrder {
    int c, n;
    __device__ __forceinline__ bool next(int i, Unit& u) const { if (i > 0 || c >= n) return false; u.pm = 0; u.pn = c & 3; return true; }
    __device__ __forceinline__ void a_ready(const Unit&) const {}
    __device__ __forceinline__ void done(const Unit&) const {}
};
struct EpiStoreBf16 {
    static constexpr bool PERM = true, AFTER_DRAIN = false;
    bf16_t* O; int ldc;
    __device__ __forceinline__ void operator()(const f32x4 (&acc)[2][2][4][2], const Unit& u, int wr, int wc, int fr, int fq) const {
        const int row0 = u.pm * BM + wr * 64 + fr, col0 = u.pn * BM + wc * 32 + 8 * fq;
#pragma unroll
        for (int ai = 0; ai < 2; ++ai)
#pragma unroll
            for (int m = 0; m < 4; ++m) { bf16_t* rowp = O + (size_t)(row0 + ai * HALF + m * 16) * ldc + col0;
#pragma unroll
                for (int bj = 0; bj < 2; ++bj) { const f32x4 v0 = acc[ai][bj][m][0], v1 = acc[ai][bj][m][1];
                    u32x4 w; w.x = cvt_pk_bf16(v0[0], v0[1]); w.y = cvt_pk_bf16(v0[2], v0[3]); w.z = cvt_pk_bf16(v1[0], v1[1]); w.w = cvt_pk_bf16(v1[2], v1[3]);
                    *(u32x4*)(rowp + bj * HALF) = w; } }
    }
};
template <class Epi, class Sched, bool ALIGN_EPI = false, bool SP2 = false>
__device__ __forceinline__ void gemm_phase(PG8_LAS unsigned char* lds, const Gemm g, const Sched& S, const Epi& E, const int tid) {
    const int wid = __builtin_amdgcn_readfirstlane(tid >> 6), lane = tid & 63, wr = wid >> 2, wc = wid & 3, fr = lane & 15, fq = lane >> 4;
    const int K = g.K, nt = K / BK;
    unsigned voffA[2], voffB[2];
#pragma unroll
    for (int i = 0; i < 2; ++i) { int R, C; stage_rc(tid * 16 + i * 8192, R, C); const int Rb = Epi::PERM ? ((R & ~31) + perm32(R & 31)) : R;
        voffA[i] = (unsigned)(R * g.ld + C) * 2u; voffB[i] = (unsigned)(Rb * g.ld + C) * 2u; }
    const size_t kstep = (size_t)(BK * 2);
    const size_t hstep = (size_t)HALF * g.ld * 2;
    const size_t tstep = 2 * hstep;
    const unsigned ldsw = (unsigned)wid * 1024u;
    const int aoff = lds_byte(wr * 64 + fr, fq * 8), boff = lds_byte(wc * 32 + fr, fq * 8);
#define PG8_SA(b, h) (((b) * 2 + (h)) * HTB)
#define PG8_SB(b, h) ((4 + (b) * 2 + (h)) * HTB)
#define PG8_STAGE(bufoff, gbase, voff) do { _Pragma("unroll") for (int _i = 0; _i < 2; ++_i) \
        __builtin_amdgcn_global_load_lds((const unsigned*)((const char*)(gbase) + (voff)[_i]), (PG8_LAS unsigned*)(lds + (bufoff) + ldsw + _i * 8192), 16, 0, 0); } while (0)
#define PG8_LDA(dst, b, h) do { _Pragma("unroll") for (int m = 0; m < 4; ++m) _Pragma("unroll") for (int k = 0; k < 2; ++k) dst[m][k] = *(const PG8_LAS bf16x8*)(lds + PG8_SA(b, h) + aoff + m * 2048 + k * 1024); } while (0)
#define PG8_LDB(dst, b, h) do { _Pragma("unroll") for (int n = 0; n < 2; ++n) _Pragma("unroll") for (int k = 0; k < 2; ++k) dst[n][k] = *(const PG8_LAS bf16x8*)(lds + PG8_SB(b, h) + boff + n * 2048 + k * 1024); } while (0)
#define PG8_MMA(ai, bj, At, Bt) do { __builtin_amdgcn_s_setprio(1); _Pragma("unroll") for (int m = 0; m < 4; ++m) _Pragma("unroll") for (int n = 0; n < 2; ++n) _Pragma("unroll") for (int k = 0; k < 2; ++k) \
        acc[ai][bj][m][n] = __builtin_amdgcn_mfma_f32_16x16x32_bf16(Bt[n][k], At[m][k], acc[ai][bj][m][n], 0, 0, 0); __builtin_amdgcn_s_setprio(0); } while (0)
#define PG8_WAIT_V(n) asm volatile("s_waitcnt vmcnt(" #n ")" ::: "memory")
#define PG8_WAIT_L(n) asm volatile("s_waitcnt lgkmcnt(" #n ")" ::: "memory")
#define PG8_BAR __builtin_amdgcn_s_barrier()
#define PG8_SCHED __builtin_amdgcn_sched_barrier(0)
    Unit cur, nxt; int ui = 0;
    if (!S.next(0, cur)) return;
    f32x4 acc[2][2][4][2];
#pragma unroll
    for (int a = 0; a < 2; ++a)
#pragma unroll
        for (int b = 0; b < 2; ++b)
#pragma unroll
            for (int m = 0; m < 4; ++m)
#pragma unroll
                for (int n = 0; n < 2; ++n) acc[a][b][m][n] = (f32x4){0.f, 0.f, 0.f, 0.f};
    bf16x8 At[4][2], B0[2][2], B1[2][2];
    const char* cA = (const char*)g.A + (size_t)cur.pm * tstep; const char* cB = (const char*)g.Bt + (size_t)cur.pn * tstep;
    S.a_ready(cur);
    if constexpr (SP2) {
        PG8_STAGE(PG8_SB(0, 0), cB, voffB); PG8_STAGE(PG8_SB(0, 1), cB + hstep, voffB); PG8_STAGE(PG8_SA(0, 0), cA, voffA); PG8_STAGE(PG8_SA(0, 1), cA + hstep, voffA);
        if (wr == 1) PG8_BAR;
        PG8_WAIT_V(2); PG8_BAR;
        PG8_STAGE(PG8_SB(1, 0), cB + kstep, voffB); PG8_STAGE(PG8_SA(1, 0), cA + kstep, voffA); PG8_STAGE(PG8_SB(1, 1), cB + hstep + kstep, voffB);
        PG8_WAIT_V(6); PG8_BAR;
    } else {
        PG8_STAGE(PG8_SB(0, 0), cB, voffB); PG8_STAGE(PG8_SA(0, 0), cA, voffA); PG8_STAGE(PG8_SB(0, 1), cB + hstep, voffB); PG8_STAGE(PG8_SA(0, 1), cA + hstep, voffA);
        if (wr == 1) PG8_BAR;
        PG8_WAIT_V(4); PG8_BAR;
        PG8_STAGE(PG8_SB(1, 0), cB + kstep, voffB); PG8_STAGE(PG8_SA(1, 0), cA + kstep, voffA); PG8_STAGE(PG8_SB(1, 1), cB + hstep + kstep, voffB);
        PG8_WAIT_V(6); PG8_BAR;
    }
    for (;;) {
        const bool has_next = S.next(ui + 1, nxt);
        const char* nA = has_next ? (const char*)g.A + (size_t)nxt.pm * tstep : cA; const char* nB = has_next ? (const char*)g.Bt + (size_t)nxt.pn * tstep : cB;
        for (int t = 0; t < nt; t += 2) {
            const bool last = (t == nt - 2);
            const char* a1 = cA + (size_t)(t + 1) * kstep;
            const char* a2 = last ? nA : cA + (size_t)(t + 2) * kstep; const char* b2 = last ? nB : cB + (size_t)(t + 2) * kstep;
            const char* a3 = a2 + kstep; const char* b3 = b2 + kstep;
            if (last && has_next) S.a_ready(nxt);
            if constexpr (SP2) {
            PG8_LDB(B0, 0, 0); PG8_LDB(B1, 0, 1); PG8_SCHED; PG8_LDA(At, 0, 0); PG8_STAGE(PG8_SA(1, 1), a1 + hstep, voffA);
            PG8_WAIT_V(8); PG8_WAIT_L(0); PG8_BAR; PG8_MMA(0, 0, At, B0); PG8_MMA(0, 1, At, B1); PG8_BAR; PG8_SCHED;
            PG8_LDA(At, 0, 1); PG8_STAGE(PG8_SB(0, 0), b2, voffB); PG8_STAGE(PG8_SB(0, 1), b2 + hstep, voffB); PG8_STAGE(PG8_SA(0, 0), a2, voffA);
            PG8_WAIT_V(8); PG8_WAIT_L(0); PG8_BAR; PG8_MMA(1, 0, At, B0); PG8_MMA(1, 1, At, B1); PG8_BAR; PG8_SCHED;
            PG8_LDB(B0, 1, 0); PG8_LDB(B1, 1, 1); PG8_SCHED; PG8_LDA(At, 1, 0); PG8_STAGE(PG8_SA(0, 1), a2 + hstep, voffA);
            PG8_WAIT_V(8); PG8_WAIT_L(0); PG8_BAR; PG8_MMA(0, 0, At, B0); PG8_MMA(0, 1, At, B1); PG8_BAR; PG8_SCHED;
            PG8_LDA(At, 1, 1); PG8_STAGE(PG8_SB(1, 0), b3, voffB); PG8_STAGE(PG8_SB(1, 1), b3 + hstep, voffB); PG8_STAGE(PG8_SA(1, 0), a3, voffA);
            PG8_WAIT_V(8); PG8_WAIT_L(0); PG8_BAR; PG8_MMA(1, 0, At, B0); PG8_MMA(1, 1, At, B1); PG8_BAR; PG8_SCHED;
            } else {
            PG8_LDB(B0, 0, 0); PG8_SCHED; PG8_LDA(At, 0, 0); PG8_STAGE(PG8_SA(1, 1), a1 + hstep, voffA);
            PG8_WAIT_L(8); PG8_BAR; PG8_WAIT_L(0); PG8_MMA(0, 0, At, B0); PG8_BAR; PG8_SCHED;
            PG8_LDB(B1, 0, 1); PG8_STAGE(PG8_SB(0, 0), b2, voffB);
            PG8_BAR; PG8_WAIT_L(0); PG8_MMA(0, 1, At, B1); PG8_BAR;
            PG8_LDA(At, 0, 1); PG8_STAGE(PG8_SA(0, 0), a2, voffA);
            PG8_BAR; PG8_WAIT_L(0); PG8_MMA(1, 0, At, B0); PG8_BAR; PG8_SCHED;
            PG8_STAGE(PG8_SB(0, 1), b2 + hstep, voffB);
            PG8_WAIT_V(6); PG8_BAR; PG8_MMA(1, 1, At, B1); PG8_BAR;
            PG8_LDB(B0, 1, 0); PG8_SCHED; PG8_LDA(At, 1, 0); PG8_STAGE(PG8_SA(0, 1), a2 + hstep, voffA);
            PG8_WAIT_L(8); PG8_BAR; PG8_WAIT_L(0); PG8_MMA(0, 0, At, B0); PG8_BAR; PG8_SCHED;
            PG8_LDB(B1, 1, 1); PG8_STAGE(PG8_SB(1, 0), b3, voffB);
            PG8_BAR; PG8_WAIT_L(0); PG8_MMA(0, 1, At, B1); PG8_BAR;
            PG8_LDA(At, 1, 1); PG8_STAGE(PG8_SA(1, 0), a3, voffA);
            PG8_BAR; PG8_WAIT_L(0); PG8_MMA(1, 0, At, B0); PG8_BAR; PG8_SCHED;
            PG8_STAGE(PG8_SB(1, 1), b3 + hstep, voffB);
            PG8_WAIT_V(6); PG8_BAR; PG8_MMA(1, 1, At, B1); PG8_BAR;
            }
        }
        if constexpr (ALIGN_EPI) { if (wr == 0) PG8_BAR; }
        if constexpr (!Epi::AFTER_DRAIN) { E(acc, cur, wr, wc, fr, fq); S.done(cur); }
        if (!has_next) break;
#pragma unroll
        for (int a = 0; a < 2; ++a)
#pragma unroll
            for (int b = 0; b < 2; ++b)
#pragma unroll
                for (int m = 0; m < 4; ++m)
#pragma unroll
                    for (int n = 0; n < 2; ++n) acc[a][b][m][n] = (f32x4){0.f, 0.f, 0.f, 0.f};
        cur = nxt; cA = nA; cB = nB; ++ui;
        if constexpr (ALIGN_EPI) { if (wr == 1) PG8_BAR; }
    }
    PG8_WAIT_V(0);
    if constexpr (!ALIGN_EPI) { if (wr == 0) PG8_BAR; }
    PG8_BAR;
    if constexpr (Epi::AFTER_DRAIN) { E.fused(acc, cur, wr, wc, fr, fq, lds, wid, lane); S.done(cur); }
#undef PG8_SA
#undef PG8_SB
#undef PG8_STAGE
#undef PG8_LDA
#undef PG8_LDB
#undef PG8_MMA
#undef PG8_WAIT_V
#undef PG8_WAIT_L
#undef PG8_BAR
#undef PG8_SCHED
}
}
#define LAS __attribute__((address_space(3)))
#define DI __device__ __forceinline__
typedef unsigned short bf16_t;
typedef float f32x4 __attribute__((ext_vector_type(4)));
typedef unsigned u32x4 __attribute__((ext_vector_type(4)));
typedef unsigned u32x2 __attribute__((ext_vector_type(2)));
constexpr int DM = 1024, SEQ = 16384, CTX = 256, MT = SEQ + CTX, FF = 2816;
constexpr int ABP = 3072, CDP = 4096, ABIN = 1824;
constexpr float EPS = 1e-6f, LOG2E = 1.4426950408889634f;
constexpr size_t MiB = 1u << 20;
constexpr size_t WS_MODX = 0, WS_MODC = 128 * 1024, CTL_ZERO_BYTES = 256 * 1024;
constexpr size_t WS_XC = 1 * MiB, WS_WINAB = 2 * MiB, WS_WOUTAB = 8 * MiB, WS_WINCD = 10 * MiB, WS_WOUTCD = 18 * MiB, WS_H = 20 * MiB;
constexpr size_t WS_FFN0 = 53 * MiB, FFN_SLOT = 16 * MiB + MiB / 2, FFN_W2OFF = 11 * MiB;
constexpr size_t WS_R = 86 * MiB, WS_U = WS_R, WS_PROJAB = WS_R, WS_VAT = 184 * MiB, WS_VBT = 189 * MiB;
constexpr size_t WS_PART = 206 * MiB;
constexpr size_t WS_HG = 53 * MiB, WS_HGD = 118 * MiB, WS_PROJCD = 120 * MiB, WS_VDT = 250 * MiB, WS_END = 267 * MiB;
constexpr size_t WS_DUMMY = 268 * MiB;
constexpr size_t WS_BAR = 80 * 1024;
constexpr int LDS_BYTES = 132 * 1024, LDS_BARST = LDS_BYTES - 16;
#ifdef DUP_PH
constexpr int NPH = 25;
#else
constexpr int NPH = 24;
#endif

struct Params { const float* in[25]; float* out; unsigned char* ws; int ph_lo, ph_hi; };

DI float bf2f(bf16_t v) { return __uint_as_float(((unsigned)v) << 16); }
DI bf16_t f2bf(float f) { unsigned u = __float_as_uint(f); return (bf16_t)((u + 0x7fffu + ((u >> 16) & 1u)) >> 16); }
DI unsigned pk2(float lo, float hi) { return (unsigned)f2bf(lo) | ((unsigned)f2bf(hi) << 16); }
#define SHX(v, o) __builtin_bit_cast(float, __builtin_amdgcn_ds_bpermute(((lane) ^ (o)) << 2, __builtin_bit_cast(int, (float)(v))))
#define DPP_ADD(v, ctrl) ((v) + __builtin_bit_cast(float, __builtin_amdgcn_update_dpp(0, __builtin_bit_cast(int, (float)(v)), (ctrl), 0xf, 0xf, false)))
DI float wave_sum(float v, int lane) {
    (void)lane;
    v = DPP_ADD(v, 0xB1); v = DPP_ADD(v, 0x4E); v = DPP_ADD(v, 0x141); v = DPP_ADD(v, 0x140);
    const int iv = __builtin_bit_cast(int, v);
    const float a = __builtin_bit_cast(float, __builtin_amdgcn_readlane(iv, 0)), b = __builtin_bit_cast(float, __builtin_amdgcn_readlane(iv, 16));
    const float c = __builtin_bit_cast(float, __builtin_amdgcn_readlane(iv, 32)), d = __builtin_bit_cast(float, __builtin_amdgcn_readlane(iv, 48));
    return (a + b) + (c + d);
}
DI float silu(float x) { return x / (1.0f + __expf(-x)); }
DI float sigmoidf_(float x) { return 1.0f / (1.0f + __expf(-x)); }
DI int swap23(int p) { return (p & ~12) | ((p & 8) >> 1) | ((p & 4) << 1); }
#define LDS_WAIT() asm volatile("s_waitcnt lgkmcnt(0)" ::: "memory")

struct SrcPlain { const float* W; int N; DI float operator()(int k, int n) const { return W[(size_t)k * N + n]; } };
struct SrcW13 { const float* w1; long d31; DI float operator()(int k, int n) const { return w1[(long)k * FF + ((n >> 8) << 7) + (n & 127) + ((n & 128) ? d31 : 0l)]; } };
template <class Src> DI void transpose_item(const Src& src, int K, bf16_t* WT, LAS float* scr, int kb, int nb, int lane) {
    const int k0 = 64 * kb, n0 = 32 * nb;
    float tv[32];
#pragma unroll
    for (int i = 0; i < 32; ++i) tv[i] = src(k0 + 2 * i + (lane >> 5), n0 + (lane & 31));
    __builtin_amdgcn_sched_barrier(0);
#pragma unroll
    for (int i = 0; i < 32; ++i) scr[(2 * i + (lane >> 5)) * 33 + (lane & 31)] = tv[i];
    LDS_WAIT();
    const int c = lane & 7;
#pragma unroll
    for (int j = 0; j < 4; ++j) { const int n = (lane >> 3) + 8 * j; const LAS float* s = scr + (8 * c) * 33 + n;
        u32x4 o; o.x = pk2(s[0 * 33], s[1 * 33]); o.y = pk2(s[2 * 33], s[3 * 33]); o.z = pk2(s[4 * 33], s[5 * 33]); o.w = pk2(s[6 * 33], s[7 * 33]);
        *(u32x4*)(WT + (size_t)(n0 + n) * K + k0 + 8 * c) = o; }
    LDS_WAIT();
}
constexpr int FFN_ITEMS = 16 * 176 + 44 * 32;
DI void convert_ffn_item(const Params& P, int l, int j, int slot, int it, LAS float* scr, int lane) {
    const size_t wo = (size_t)(l * 2 + j) * DM * FF;
    bf16_t* W13t = (bf16_t*)(P.ws + WS_FFN0 + slot * FFN_SLOT); bf16_t* W2t = (bf16_t*)(P.ws + WS_FFN0 + slot * FFN_SLOT + FFN_W2OFF);
    if (it < 16 * 176) { SrcW13 s{P.in[7] + wo, (long)(P.in[8] - P.in[7])}; transpose_item(s, DM, W13t, scr, it / 176, it % 176, lane); }
    else { it -= 16 * 176; SrcPlain s{P.in[9] + wo, DM}; transpose_item(s, FF, W2t, scr, it / 32, it % 32, lane); }
}
DI void phase_prologue(const Params& P, LAS unsigned char* lds, int tid, int wave, int lane, bool second) {
    LAS float* scr = (LAS float*)(lds + wave * 16384);
    const int gw = blockIdx.x * 8 + wave, ngw = gridDim.x * 8;
    constexpr int I_AB = 16 * 57, I_O = 16 * 32, I_CD = 16 * 128;
    constexpr int NIT = 2 * FFN_ITEMS + I_AB + I_O + I_CD + I_O;
    for (int it = gw; it < NIT; it += ngw) {
        int r = it;
        if (r < FFN_ITEMS) { convert_ffn_item(P, 0, 0, 0, r, scr, lane); continue; } r -= FFN_ITEMS;
        if (r < FFN_ITEMS) { convert_ffn_item(P, 0, 1, 1, r, scr, lane); continue; } r -= FFN_ITEMS;
        if (r < I_AB) { SrcPlain s{P.in[10], ABIN}; transpose_item(s, DM, (bf16_t*)(P.ws + WS_WINAB), scr, r / 57, r % 57, lane); continue; } r -= I_AB;
        if (r < I_O) { SrcPlain s{P.in[17], DM}; transpose_item(s, DM, (bf16_t*)(P.ws + WS_WOUTAB), scr, r / 32, r % 32, lane); continue; } r -= I_O;
        if (r < I_CD) { SrcPlain s{P.in[18], CDP}; transpose_item(s, DM, (bf16_t*)(P.ws + WS_WINCD), scr, r / 128, r % 128, lane); continue; } r -= I_CD;
        { SrcPlain s{P.in[24], DM}; transpose_item(s, DM, (bf16_t*)(P.ws + WS_WOUTCD), scr, r / 32, r % 32, lane); }
    }
    __syncthreads();
    {
        LAS float* As = (LAS float*)lds; LAS float* Bs = (LAS float*)(lds + 64 * 33 * 4);
        const float* Win = P.in[10]; const float* gk = P.in[15]; const float* wu = P.in[16];
        bf16_t* Wt = (bf16_t*)(P.ws + WS_WINAB);
        for (int t = blockIdx.x; t < 256; t += gridDim.x) {
            const int n0 = (t >> 4) * 64, k0 = (t & 15) * 64, kl = tid & 63, ng = tid >> 6;
            float acc[8];
#pragma unroll
            for (int i = 0; i < 8; ++i) acc[i] = 0.f;
            for (int jc = 0; jc < 8; ++jc) { const int j0 = jc * 32;
                { const int kk = tid >> 3, jj4 = (tid & 7) * 4, jb = tid >> 4, nn4 = (tid & 15) * 4;
                  const f32x4 av = *(const f32x4*)(Win + (size_t)(k0 + kk) * ABIN + 1536 + j0 + jj4); const f32x4 bv = *(const f32x4*)(wu + (size_t)(j0 + jb) * DM + n0 + nn4); const float gv = gk[j0 + jb];
                  As[kk * 33 + jj4] = av.x; As[kk * 33 + jj4 + 1] = av.y; As[kk * 33 + jj4 + 2] = av.z; As[kk * 33 + jj4 + 3] = av.w;
                  Bs[jb * 64 + nn4] = gv * bv.x; Bs[jb * 64 + nn4 + 1] = gv * bv.y; Bs[jb * 64 + nn4 + 2] = gv * bv.z; Bs[jb * 64 + nn4 + 3] = gv * bv.w; }
                __syncthreads();
#pragma unroll 8
                for (int jj = 0; jj < 32; ++jj) { const float a = As[kl * 33 + jj];
#pragma unroll
                    for (int i = 0; i < 8; ++i) acc[i] += a * Bs[jj * 64 + ng * 8 + i]; }
                __syncthreads();
            }
#pragma unroll
            for (int i = 0; i < 8; ++i) Wt[(size_t)(ABIN + n0 + ng * 8 + i) * DM + k0 + kl] = f2bf(acc[i]);
        }
        { u32x4* z = (u32x4*)(Wt + (size_t)2848 * DM); const int nz = 224 * DM * 2 / 16;
          unsigned zz_ = 0u; asm volatile("" : "+v"(zz_));
          for (int i = blockIdx.x * 512 + tid; i < nz; i += gridDim.x * 512) z[i] = (u32x4){zz_, zz_, zz_, zz_}; }
    }
    { const f32x4* src = (const f32x4*)P.in[2]; f32x4* dst = (f32x4*)(P.ws + WS_XC); for (int i = blockIdx.x * 512 + tid; i < CTX * DM / 4; i += gridDim.x * 512) dst[i] = src[i]; }
    {
        float* modx = (float*)(P.ws + (second ? WS_DUMMY : WS_MODX)); float* modc = (float*)(P.ws + (second ? WS_DUMMY + 128 * 1024 : WS_MODC));
        const float* cv = P.in[1]; const float* cc = P.in[3];
        for (int it = blockIdx.x; it < 2 * 18 * 4; it += gridDim.x) {
            const int l = it / (18 * 4), r = it % (18 * 4), cb = r / 4, kc = r % 4, n = cb * 512 + tid;
            float ax = 0.f, ac = 0.f;
            for (int kb = kc * 256; kb < kc * 256 + 256; kb += 32) {
                const float* w = P.in[5] + (size_t)l * DM * 9216 + (size_t)kb * 9216 + n;
                float wv[32];
#pragma unroll
                for (int kk = 0; kk < 32; ++kk) wv[kk] = w[(size_t)kk * 9216];
                __builtin_amdgcn_sched_barrier(0);
#pragma unroll
                for (int kk = 0; kk < 32; ++kk) { ax += silu(cv[kb + kk]) * wv[kk]; ac += silu(cc[kb + kk]) * wv[kk]; }
            }
            if (kc == 0) { const float b = P.in[6][l * 9216 + n]; ax += b; ac += b; }
            atomicAdd(modx + l * 9216 + n, ax); atomicAdd(modc + l * 9216 + n, ac);
        }
    }
}

DI void phase_normmod(const Params& P, int l, int idx, bool first, int nrows, int nsplit, int wave, int lane) {
    const float* g = P.in[4] + (l * 3 + idx) * DM;
    const float* modx = (const float*)(P.ws + WS_MODX) + l * 9216; const float* modc = (const float*)(P.ws + WS_MODC) + l * 9216;
    bf16_t* H = (bf16_t*)(P.ws + WS_H);
    const int gw = blockIdx.x * 8 + wave, ngw = gridDim.x * 8;
    for (int m = gw; m < nrows; m += ngw) {
        const bool isC = m >= SEQ;
        const float* src = isC ? ((first ? P.in[2] : (const float*)(P.ws + WS_XC)) + (size_t)(m - SEQ) * DM) : ((first ? P.in[0] : (const float*)P.out) + (size_t)m * DM);
        const float* mod = isC ? modc : modx; const float* shift = mod + (idx * 3) * DM; const float* scale = mod + (idx * 3 + 1) * DM;
        f32x4 v[4]; float ss = 0.f;
#pragma unroll
        for (int j = 0; j < 4; ++j) { v[j] = ((const f32x4*)src)[64 * j + lane]; ss += (v[j].x * v[j].x + v[j].y * v[j].y) + (v[j].z * v[j].z + v[j].w * v[j].w); }
        if (isC && nsplit > 0) {
            const float* part = (const float*)(P.ws + WS_PART) + (size_t)(m - SEQ) * DM; float* xc = (float*)(P.ws + WS_XC) + (size_t)(m - SEQ) * DM;
            for (int sp = 0; sp < nsplit; ++sp) {
#pragma unroll
                for (int j = 0; j < 4; ++j) v[j] += ((const f32x4*)(part + (size_t)sp * CTX * DM))[64 * j + lane]; }
            ss = 0.f;
#pragma unroll
            for (int j = 0; j < 4; ++j) { ((f32x4*)xc)[64 * j + lane] = v[j]; ss += (v[j].x * v[j].x + v[j].y * v[j].y) + (v[j].z * v[j].z + v[j].w * v[j].w); }
        }
        ss = wave_sum(ss, lane); const float rstd = rsqrtf(ss * (1.0f / DM) + EPS);
#pragma unroll
        for (int j = 0; j < 4; ++j) { const int col = 4 * (64 * j + lane);
            const f32x4 gv = *(const f32x4*)(g + col), sc = *(const f32x4*)(scale + col), sh = *(const f32x4*)(shift + col);
            const f32x4 y = (v[j] * rstd * gv) * (sc + 1.0f) + sh;
            u32x2 w; w.x = pk2(y.x, y.y); w.y = pk2(y.z, y.w); *(u32x2*)(H + (size_t)m * DM + col) = w; }
    }
}

DI void phase_postAB(const Params& P, LAS unsigned char* lds, int tid, int wave, int lane, bool second) {
    bf16_t* proj = (bf16_t*)(P.ws + WS_PROJAB); bf16_t* VAT = (bf16_t*)(P.ws + WS_VAT); bf16_t* VBT = (bf16_t*)(P.ws + WS_VBT);
    LAS bf16_t* vt = (LAS bf16_t*)lds; constexpr int VTS = 18;
    const float aqn = P.in[11][lane], akn = P.in[12][lane], bqn0 = P.in[13][lane], bqn1 = P.in[13][64 + (lane & 31)], bkn0 = P.in[14][lane], bkn1 = P.in[14][64 + (lane & 31)];
    const float invA = exp2f(-(float)(lane & 15) * (13.287712379549449f / 16.0f)), invB = exp2f(-(float)(lane & 7) * (13.287712379549449f / 8.0f));
    const float sgnA = (lane & 16) ? 1.f : -1.f, sgnB = (lane & 8) ? 1.f : -1.f;
    const float qsA = 0.125f * LOG2E, qsB = 0.10206207261596577f * LOG2E;
    const bool lo = lane < 32;
    for (int tile = blockIdx.x; tile < MT / 16; tile += gridDim.x) {
        for (int i = 0; i < 2; ++i) {
            const int tt = wave * 2 + i, m = tile * 16 + tt, pp = swap23(tt); const bool rot = m < SEQ;
            bf16_t* raw = proj + (size_t)m * ABP;
            const bf16_t* rawi = raw; if (second) raw = (bf16_t*)(P.ws + WS_DUMMY) + (size_t)(m & 1023) * ABP;
            bf16_t rq[8], rk[2], rbq0[8], rbq1[8], rl[4], rkn[8], rvv[8], xv[2], rkr;
#pragma unroll
            for (int hh = 0; hh < 8; ++hh) { rq[hh] = rawi[hh * 64 + lane]; rbq0[hh] = rawi[768 + hh * 96 + lane]; rbq1[hh] = rawi[768 + hh * 96 + 64 + (lane & 31)];
                rkn[hh] = rawi[ABIN + hh * 128 + lane]; rvv[hh] = rawi[ABIN + hh * 128 + 64 + lane]; }
#pragma unroll
            for (int hh = 0; hh < 2; ++hh) { rk[hh] = rawi[512 + hh * 64 + lane]; xv[hh] = rawi[640 + hh * 64 + lane]; }
#pragma unroll
            for (int j = 0; j < 4; ++j) rl[j] = rawi[1536 + 64 * j + lane];
            rkr = rawi[1792 + (lane & 31)];
            __builtin_amdgcn_sched_barrier(0);
            float xq[8], xk[2], xbq0[8], xbq1[8], xl[4], xkn[8], xvv[8];
#pragma unroll
            for (int hh = 0; hh < 8; ++hh) { xq[hh] = bf2f(rq[hh]); xbq0[hh] = bf2f(rbq0[hh]); xbq1[hh] = lo ? bf2f(rbq1[hh]) : 0.f; xkn[hh] = bf2f(rkn[hh]); xvv[hh] = bf2f(rvv[hh]); }
#pragma unroll
            for (int hh = 0; hh < 2; ++hh) xk[hh] = bf2f(rk[hh]);
#pragma unroll
            for (int j = 0; j < 4; ++j) xl[j] = bf2f(rl[j]);
            const float kr = lo ? bf2f(rkr) : 0.f;
            const float pr = (float)(m >> 6), pc = (float)(m & 63);
            float cA = 1.f, sA = 0.f, cB = 1.f, sB = 0.f;
            if (rot) { const float angA = ((lane & 32) ? pc : pr) * invA, angB = ((lane & 16) ? pc : pr) * invB; cA = cosf(angA); sA = sinf(angA); cB = cosf(angB); sB = sinf(angB); }
#pragma unroll
            for (int hh = 0; hh < 8; ++hh) { const float x = xq[hh]; const float ss = wave_sum(x * x, lane);
                float y = x * rsqrtf(ss * (1.f / 64.f) + EPS) * aqn; const float pt = SHX(y, 16); y = y * cA + sgnA * pt * sA; raw[hh * 64 + lane] = f2bf(y * qsA); }
#pragma unroll
            for (int hh = 0; hh < 2; ++hh) { const float x = xk[hh]; const float ss = wave_sum(x * x, lane);
                float y = x * rsqrtf(ss * (1.f / 64.f) + EPS) * akn; const float pt = SHX(y, 16); y = y * cA + sgnA * pt * sA; raw[512 + hh * 64 + lane] = f2bf(y);
                vt[(hh * 64 + lane) * VTS + pp] = xv[hh]; }
#pragma unroll
            for (int hh = 0; hh < 8; ++hh) { const float x0 = xbq0[hh], x1 = xbq1[hh];
                const float ss = wave_sum(x0 * x0 + x1 * x1, lane); const float rs = rsqrtf(ss * (1.f / 96.f) + EPS);
                const float y0 = x0 * rs * bqn0; float y1 = x1 * rs * bqn1; const float pt = SHX(y1, 8); y1 = y1 * cB + sgnB * pt * sB;
                raw[768 + hh * 96 + lane] = f2bf(y0 * qsB); if (lo) raw[768 + hh * 96 + 64 + lane] = f2bf(y1 * qsB); }
            const float rkv = rsqrtf(wave_sum(xl[0] * xl[0] + xl[1] * xl[1] + xl[2] * xl[2] + xl[3] * xl[3], lane) * (1.f / 256.f) + EPS);
#pragma unroll
            for (int hh = 0; hh < 8; ++hh) { const float kn = xkn[hh] * rkv; const float vv = xvv[hh] * rkv;
                const float ss = wave_sum(kn * kn + kr * kr, lane); const float rs = rsqrtf(ss * (1.f / 96.f) + EPS);
                const float y0 = kn * rs * bkn0; float y1 = kr * rs * bkn1; const float pt = SHX(y1, 8); y1 = y1 * cB + sgnB * pt * sB;
                raw[ABIN + hh * 128 + lane] = f2bf(y0); if (lo) raw[ABIN + hh * 128 + 64 + lane] = f2bf(y1);
                vt[(128 + hh * 64 + lane) * VTS + pp] = f2bf(vv); }
        }
        __syncthreads();
        for (int c = tid; c < 640 * 2; c += 512) { const int row = c >> 1, c8 = c & 1; const LAS unsigned* s = (const LAS unsigned*)(vt + row * VTS + 8 * c8);
            u32x4 o; o.x = s[0]; o.y = s[1]; o.z = s[2]; o.w = s[3];
            bf16_t* dst = row < 128 ? VAT + (size_t)row * MT : VBT + (size_t)(row - 128) * MT;
            if (second) dst = (bf16_t*)(P.ws + WS_DUMMY + 8 * MiB) + (size_t)row * 1024 - tile * 16 + (tile & 31) * 16;
            *(u32x4*)(dst + tile * 16 + 8 * c8) = o; }
        __syncthreads();
    }
}

typedef short bf16x8 __attribute__((ext_vector_type(8)));
typedef float f32x16 __attribute__((ext_vector_type(16)));
typedef float f32x2_t __attribute__((ext_vector_type(2)));
typedef __bf16 bf16x2_t __attribute__((ext_vector_type(2)));
DI unsigned cvtpk(float lo, float hi) { f32x2_t v = {lo, hi}; bf16x2_t b = __builtin_convertvector(v, bf16x2_t); return __builtin_bit_cast(unsigned, b); }
DI bf16x8 pack8(const f32x16& p, int s8) { u32x4 w; w.x = cvtpk(p[s8 + 0], p[s8 + 1]); w.y = cvtpk(p[s8 + 2], p[s8 + 3]); w.z = cvtpk(p[s8 + 4], p[s8 + 5]); w.w = cvtpk(p[s8 + 6], p[s8 + 7]); return __builtin_bit_cast(bf16x8, w); }
#define MFMA32(a, b, c) __builtin_amdgcn_mfma_f32_32x32x16_bf16((a), (b), (c), 0, 0, 0)
template <int DQK, bool NA, int EXPV = 0> DI void attn_unit(const bf16_t* proj, int pitch, int qcol, int kcol, const bf16_t* VT, bf16_t* H, int ocol, int q0, int t_lo, int t_hi, LAS unsigned char* lds, int tid, int wave, int lane,
                                             const float* rpb = nullptr, int nwin = 0, int krow0 = 0) {
    constexpr int KS = DQK * 2 + 16, KBUF = 64 * KS, VS = 144, VBUF = 64 * VS, CPR = DQK / 8, NDS = DQK / 16;
    LAS unsigned char* Kb = lds; LAS unsigned char* Vb = lds + 2 * KBUF;
    const int r32 = lane & 31, h = lane >> 5;
    const int k0r = tid / CPR, k0c = tid % CPR, k1r = (512 + tid) / CPR, k1c = (512 + tid) % CPR, vrow = tid >> 3, vc = tid & 7;
    const bool two = (DQK == 96) && tid < 256;
    bf16x8 qf[NDS];
    { const bf16_t* qp = proj + (size_t)(q0 + wave * 32 + r32) * pitch + qcol + 8 * h;
#pragma unroll
      for (int ds = 0; ds < NDS; ++ds) qf[ds] = *(const bf16x8*)(qp + 16 * ds); }
    f32x16 o0, o1, negm;
#pragma unroll
    for (int r = 0; r < 16; ++r) { o0[r] = 0.f; o1[r] = 0.f; negm[r] = 0.f; }
    float mhat = 0.f, l = 0.f;
    unsigned zz_ = 0u; asm volatile("" : "+v"(zz_)); u32x4 kr0, kr1 = (u32x4){zz_, zz_, zz_, zz_}, vr;
    LAS float* rpbs = (LAS float*)(lds + 2 * KBUF + 2 * VBUF);
    int na_r = 0, na_c = 0, na_rs = 0, na_cs = 0;
    if (NA) { if (tid < 465) rpbs[tid] = rpb[tid] * LOG2E; na_r = (q0 >> 6) + (wave >> 1); na_c = 32 * (wave & 1) + r32; na_rs = min(max(na_r - 4, 0), 248); na_cs = min(max(na_c - 8, 0), 48); }
#define AT_KV0(t) (NA ? ((t) < nwin ? (krow0 + (t)) * 64 : SEQ + ((t) - nwin) * 64) : (t) * 64)
#define AT_GLOAD(t) do { const int kv0_ = AT_KV0(t); kr0 = *(const u32x4*)(proj + (size_t)(kv0_ + k0r) * pitch + kcol + 8 * k0c); \
        if (two) kr1 = *(const u32x4*)(proj + (size_t)(kv0_ + k1r) * pitch + kcol + 8 * k1c); vr = *(const u32x4*)(VT + (size_t)vrow * MT + kv0_ + 8 * vc); } while (0)
#define AT_LSTORE(b) do { *(LAS u32x4*)(Kb + (b) * KBUF + k0r * KS + 16 * k0c) = kr0; if (two) *(LAS u32x4*)(Kb + (b) * KBUF + k1r * KS + 16 * k1c) = kr1; \
        *(LAS u32x4*)(Vb + (b) * VBUF + vrow * VS + 16 * vc) = vr; } while (0)
    AT_GLOAD(t_lo); AT_LSTORE(0); __syncthreads();
    if (t_lo + 1 < t_hi) AT_GLOAD(t_lo + 1);
    for (int t = t_lo; t < t_hi; ++t) {
        const int b = (t - t_lo) & 1;
        if (EXPV != 1 && t + 1 < t_hi) AT_LSTORE(b ^ 1);
        if (EXPV != 1 && t + 2 < t_hi) AT_GLOAD(t + 2);
        const int na_kr = krow0 + t;
        const bool active = !NA || t >= nwin || (na_kr >= na_rs && na_kr < na_rs + 8);
        if (active) {
        f32x16 p0, p1;
        bf16x8 vf0[4], vf1[4];
        { bf16x8 kf0[NDS], kf1[NDS];
          const LAS unsigned char* kb = Kb + b * KBUF + r32 * KS + 16 * h; const LAS unsigned char* vb = Vb + b * VBUF + r32 * VS + 16 * h;
#pragma unroll
          for (int ds = 0; ds < NDS; ++ds) { kf0[ds] = *(const LAS bf16x8*)(kb + 32 * ds); kf1[ds] = *(const LAS bf16x8*)(kb + 32 * KS + 32 * ds); }
          __builtin_amdgcn_sched_barrier(0);
#pragma unroll
          for (int ds = 0; ds < NDS; ++ds) {
              if (ds == 0) { p0 = MFMA32(kf0[0], qf[0], negm); p1 = MFMA32(kf1[0], qf[0], negm); } else { p0 = MFMA32(kf0[ds], qf[ds], p0); p1 = MFMA32(kf1[ds], qf[ds], p1); }
              if (ds < 4) { vf0[ds] = *(const LAS bf16x8*)(vb + 32 * ds); vf1[ds] = *(const LAS bf16x8*)(vb + 32 * VS + 32 * ds); }
              __builtin_amdgcn_sched_barrier(0); } }
        if (NA && t < nwin) { const LAS float* bp = rpbs + (na_kr - na_r + 7) * 31 + 15 - na_c;
#pragma unroll
            for (int r = 0; r < 16; ++r) { const int kc = (r & 3) + 8 * (r >> 2) + 4 * h;
                { const bool ok = kc >= na_cs && kc < na_cs + 16; p0[r] = ok ? p0[r] + bp[ok ? kc : na_c] : -1e30f; }
                { const int kc1 = kc + 32; const bool ok = kc1 >= na_cs && kc1 < na_cs + 16; p1[r] = ok ? p1[r] + bp[ok ? kc1 : na_c] : -1e30f; } } }
        float mt = 0.f;
        if (EXPV != 2) { mt = __builtin_fmaxf(__builtin_fmaxf(p0[0], p1[0]), p0[1]);
#pragma unroll
        for (int r = 1; r < 16; r += 1) mt = __builtin_fmaxf(__builtin_fmaxf(mt, p1[r]), r + 1 < 16 ? p0[r + 1] : p1[r]);
        mt = fmaxf(mt, SHX(mt, 32)); }
        if (EXPV != 2 && __any(mt > 8.0f)) {
            const float dlt = fmaxf(mt, 0.f), alpha = __builtin_amdgcn_exp2f(-dlt); mhat += dlt;
#pragma unroll
            for (int r = 0; r < 16; ++r) { p0[r] -= dlt; p1[r] -= dlt; negm[r] = -mhat; }
            l *= alpha; o0 = o0 * alpha; o1 = o1 * alpha;
        }
        float la = 0.f;
#pragma unroll
        for (int r = 0; r < 16; ++r) { if (EXPV != 2) { p0[r] = __builtin_amdgcn_exp2f(p0[r]); p1[r] = __builtin_amdgcn_exp2f(p1[r]); la += p0[r]; la += p1[r]; } }
        l += la;
        bf16x8 pb[4]; pb[0] = pack8(p0, 0); pb[1] = pack8(p0, 8); pb[2] = pack8(p1, 0); pb[3] = pack8(p1, 8);
#pragma unroll
        for (int ks = 0; ks < 4; ++ks) { o0 = MFMA32(vf0[ks], pb[ks], o0); o1 = MFMA32(vf1[ks], pb[ks], o1); }
        }
        __syncthreads();
    }
#undef AT_GLOAD
#undef AT_KV0
#undef AT_LSTORE
    l += SHX(l, 32); const float il = 1.0f / l;
    bf16_t* op = H + (size_t)(q0 + wave * 32 + r32) * DM + ocol + 4 * h;
#pragma unroll
    for (int g = 0; g < 4; ++g) {
        u32x2 w0; w0.x = cvtpk(o0[4 * g] * il, o0[4 * g + 1] * il); w0.y = cvtpk(o0[4 * g + 2] * il, o0[4 * g + 3] * il); *(u32x2*)(op + 8 * g) = w0;
        u32x2 w1; w1.x = cvtpk(o1[4 * g] * il, o1[4 * g + 1] * il); w1.y = cvtpk(o1[4 * g + 2] * il, o1[4 * g + 3] * il); *(u32x2*)(op + 32 + 8 * g) = w1; }
}
DI void phase_attn(const Params& P, LAS unsigned char* lds, int tid, int wave, int lane, bool second) {
    const bf16_t* proj = (const bf16_t*)(P.ws + WS_PROJAB); const bf16_t* VAT = (const bf16_t*)(P.ws + WS_VAT); const bf16_t* VBT = (const bf16_t*)(P.ws + WS_VBT);
    bf16_t* H = (bf16_t*)(P.ws + WS_H);
    for (int u = blockIdx.x; u < 1040; u += gridDim.x) {
        int hd, q0, t_lo;
        if (u < 1024) { const int i = u >> 8, r = u & 255, x = r & 7, j = r >> 3; hd = (i >> 1) * 8 + x; q0 = (j + 32 * (i & 1)) * 256; t_lo = 0; }
        else { hd = u - 1024; q0 = SEQ; t_lo = SEQ / 64; }
#ifdef ATTN_EXPV
        if (second) { bf16_t* Hd = (bf16_t*)(P.ws + WS_DUMMY);
            if (hd < 8) attn_unit<64, false, ATTN_EXPV>(proj, ABP, hd * 64, 512 + (hd >> 2) * 64, VAT + (size_t)(hd >> 2) * 64 * MT, Hd, hd * 64, q0 & 8191, t_lo, MT / 64, lds, tid, wave, lane);
            else { const int hb = hd - 8; attn_unit<96, false, ATTN_EXPV>(proj, ABP, 768 + hb * 96, ABIN + hb * 128, VBT + (size_t)hb * 64 * MT, Hd, 512 + hb * 64, q0 & 8191, t_lo, MT / 64, lds, tid, wave, lane); }
            continue; }
#endif
        if (hd < 8) attn_unit<64, false>(proj, ABP, hd * 64, 512 + (hd >> 2) * 64, VAT + (size_t)(hd >> 2) * 64 * MT, H, hd * 64, q0, t_lo, MT / 64, lds, tid, wave, lane);
        else { const int hb = hd - 8; attn_unit<96, false>(proj, ABP, 768 + hb * 96, ABIN + hb * 128, VBT + (size_t)hb * 64 * MT, H, 512 + hb * 64, q0, t_lo, MT / 64, lds, tid, wave, lane); }
    }
}

DI void phase_postCD(const Params& P, LAS unsigned char* lds, int tid, int wave, int lane, bool second) {
    bf16_t* proj = (bf16_t*)(P.ws + WS_PROJCD); bf16_t* VDT = (bf16_t*)(P.ws + WS_VDT);
    LAS bf16_t* vt = (LAS bf16_t*)lds; constexpr int VTS = 18;
    const float dqn = P.in[21][lane] * (0.125f * LOG2E), dkn = P.in[22][lane];
    for (int tile = blockIdx.x; tile < MT / 16; tile += gridDim.x) {
        for (int i = 0; i < 2; ++i) {
            const int tt = wave * 2 + i, m = tile * 16 + tt, pp = swap23(tt);
            bf16_t* raw = proj + (size_t)m * CDP; const bf16_t* rawi = raw; if (second) raw = (bf16_t*)(P.ws + WS_DUMMY) + (size_t)(m & 1023) * CDP;
            float xq[8], xk[8]; bf16_t rq[8], rk[8], xv[8];
#pragma unroll
            for (int hh = 0; hh < 8; ++hh) { rq[hh] = rawi[2560 + hh * 64 + lane]; rk[hh] = rawi[3072 + hh * 64 + lane]; xv[hh] = rawi[3584 + hh * 64 + lane]; }
            __builtin_amdgcn_sched_barrier(0);
#pragma unroll
            for (int hh = 0; hh < 8; ++hh) { xq[hh] = bf2f(rq[hh]); xk[hh] = bf2f(rk[hh]); }
#pragma unroll
            for (int hh = 0; hh < 8; ++hh) {
                { const float x = xq[hh]; const float ss = wave_sum(x * x, lane); raw[2560 + hh * 64 + lane] = f2bf(x * rsqrtf(ss * (1.f / 64.f) + EPS) * dqn); }
                { const float x = xk[hh]; const float ss = wave_sum(x * x, lane); raw[3072 + hh * 64 + lane] = f2bf(x * rsqrtf(ss * (1.f / 64.f) + EPS) * dkn); }
                vt[(hh * 64 + lane) * VTS + pp] = xv[hh]; }
        }
        __syncthreads();
        for (int c = tid; c < 512 * 2; c += 512) { const int row = c >> 1, c8 = c & 1; const LAS unsigned* s = (const LAS unsigned*)(vt + row * VTS + 8 * c8);
            u32x4 o; o.x = s[0]; o.y = s[1]; o.z = s[2]; o.w = s[3];
            bf16_t* dst = VDT + (size_t)row * MT + tile * 16; if (second) dst = (bf16_t*)(P.ws + WS_DUMMY + 8 * MiB) + (size_t)row * 1024 + (tile & 31) * 16;
            *(u32x4*)(dst + 8 * c8) = o; }
        __syncthreads();
    }
}
DI void phase_na(const Params& P, LAS unsigned char* lds, int tid, int wave, int lane) {
    const bf16_t* proj = (const bf16_t*)(P.ws + WS_PROJCD); const bf16_t* VDT = (const bf16_t*)(P.ws + WS_VDT); bf16_t* H = (bf16_t*)(P.ws + WS_H);
    for (int u = blockIdx.x; u < 512; u += gridDim.x) {
        const int hh = u & 7, r0 = (u >> 3) * 4;
        const int krow0 = min(max(r0 - 4, 0), 248), klast = min(max(r0 - 1, 0), 248) + 7, nwin = klast - krow0 + 1;
        attn_unit<64, true>(proj, CDP, 2560 + hh * 64, 3072 + hh * 64, VDT + (size_t)hh * 64 * MT, H, 512 + hh * 64, r0 * 64, 0, nwin + CTX / 64, lds, tid, wave, lane, P.in[23] + hh * 465, nwin, krow0);
    }
}
constexpr int HS = 144;
DI int hg_rowbase(int R) { return R < 256 ? R * 64 : SEQ + (R - 256) * 64; }
#define MFMA32(a, b, c) __builtin_amdgcn_mfma_f32_32x32x16_bf16((a), (b), (c), 0, 0, 0)
DI void hgrn_gates(const Params& P, const bf16_t* proj, int rowbase, int hh, int tid, LAS float* segtot, LAS float* gmids, float (&gc)[16], float (&kin)[16], float& gtot, float& gmid) {
    const int dir = tid >> 8, seg = (tid >> 6) & 3, k = tid & 63, ch = hh * 64 + k;
    const float b0 = P.in[19][dir * 512 + ch], b1 = P.in[19][1024 + dir * 512 + ch]; const float lb = 1.0f / (1.0f + __expf(b0 - b1));
    const bf16_t* zp = proj + (size_t)(rowbase + 16 * seg) * CDP + 512 + dir * 512 + ch;
    float g[16]; bf16_t rz[16];
#pragma unroll
    for (int j = 0; j < 16; ++j) rz[j] = zp[(size_t)j * CDP];
    __builtin_amdgcn_sched_barrier(0);
#pragma unroll
    for (int j = 0; j < 16; ++j) { const float z = bf2f(rz[j]); const float f = lb + (1.0f - lb) * sigmoidf_(z); g[j] = __logf(f); kin[j] = 1.0f - f; }
    if (dir == 0) { float a = 0.f;
#pragma unroll
        for (int j = 0; j < 16; ++j) { a += g[j]; gc[j] = a; } }
    else { float a = 0.f;
#pragma unroll
        for (int j = 15; j >= 0; --j) { a += g[j]; gc[j] = a; } }
    segtot[(dir * 4 + seg) * 64 + k] = dir == 0 ? gc[15] : gc[0];
    __syncthreads();
    float off = 0.f; gtot = 0.f;
#pragma unroll
    for (int s2 = 0; s2 < 4; ++s2) { const float v = segtot[(dir * 4 + s2) * 64 + k]; gtot += v; if (dir == 0 ? (s2 < seg) : (s2 > seg)) off += v; }
#pragma unroll
    for (int j = 0; j < 16; ++j) gc[j] += off;
    if (dir == 0 && seg == 1) gmids[k] = gc[15];
    if (dir == 1 && seg == 2) gmids[64 + k] = gc[0];
    __syncthreads();
    gmid = gmids[dir * 64 + k];
}
DI void phase_hgrn1(const Params& P, LAS unsigned char* lds, int tid, int wave, int lane) {
    const bf16_t* proj = (const bf16_t*)(P.ws + WS_PROJCD); float* HG = (float*)(P.ws + WS_HG); float* HGD = (float*)(P.ws + WS_HGD);
    LAS unsigned char* KdT = lds; LAS unsigned char* VTl = lds + 2 * 64 * HS; LAS float* segtot = (LAS float*)(lds + 3 * 64 * HS); LAS float* gmids = segtot + 512;
    const int r32 = lane & 31, h = lane >> 5;
    for (int it = blockIdx.x; it < 260 * 8; it += gridDim.x) {
        const int R = it >> 3, hh = it & 7, rowbase = hg_rowbase(R);
        float gc[16], kin[16], gtot, gmid;
        const u32x4 vw = *(const u32x4*)(proj + (size_t)(rowbase + (tid >> 3)) * CDP + 1536 + hh * 64 + (tid & 7) * 8);
        hgrn_gates(P, proj, rowbase, hh, tid, segtot, gmids, gc, kin, gtot, gmid);
        const int dir = tid >> 8, seg = (tid >> 6) & 3, k = tid & 63;
        { u32x4 w0, w1; float e[16];
#pragma unroll
          for (int j = 0; j < 16; ++j) e[j] = kin[j] * __expf(gtot - gc[j]);
          w0.x = pk2(e[0], e[1]); w0.y = pk2(e[2], e[3]); w0.z = pk2(e[4], e[5]); w0.w = pk2(e[6], e[7]); w1.x = pk2(e[8], e[9]); w1.y = pk2(e[10], e[11]); w1.z = pk2(e[12], e[13]); w1.w = pk2(e[14], e[15]);
          LAS unsigned char* dst = KdT + (dir * 64 + k) * HS + 32 * seg; *(LAS u32x4*)dst = w0; *(LAS u32x4*)(dst + 16) = w1; }
        { const int s = tid >> 3, v8 = (tid & 7) * 8; const u32x4 w = vw;
          const unsigned ww[4] = {w.x, w.y, w.z, w.w};
#pragma unroll
          for (int i = 0; i < 8; ++i) *(LAS bf16_t*)(VTl + (v8 + i) * HS + 2 * s) = (bf16_t)((ww[i >> 1] >> ((i & 1) * 16)) & 0xffffu); }
        const size_t idx = (size_t)(R * 8 + hh) * 2;
        if (seg == 0) HGD[(idx + dir) * 64 + k] = __expf(gtot);
        __syncthreads();
        { const int d = wave >> 2, vb = (wave >> 1) & 1, kb = wave & 1;
          f32x16 acc;
#pragma unroll
          for (int r = 0; r < 16; ++r) acc[r] = 0.f;
          const LAS unsigned char* ap = VTl + (32 * vb + r32) * HS + 16 * h; const LAS unsigned char* bp = KdT + (d * 64 + 32 * kb + r32) * HS + 16 * h;
#pragma unroll
          for (int ss = 0; ss < 4; ++ss) acc = MFMA32(*(const LAS bf16x8*)(ap + 32 * ss), *(const LAS bf16x8*)(bp + 32 * ss), acc);
          float* out = HG + (idx + d) * 4096 + 32 * kb + r32;
#pragma unroll
          for (int r = 0; r < 16; ++r) out[(size_t)(32 * vb + (r & 3) + 8 * (r >> 2) + 4 * h) * 64] = acc[r]; }
        __syncthreads();
    }
}
DI void phase_hgrn2(const Params& P, int tid, bool second) {
    float* HG = (float*)(P.ws + WS_HG); float* HGo = second ? (float*)(P.ws + WS_DUMMY) : HG; const float* HGD = (const float*)(P.ws + WS_HGD);
    for (int e = blockIdx.x * 512 + tid; e < 65536; e += gridDim.x * 512) {
        const int hh = e >> 13, dir = (e >> 12) & 1, vk = e & 4095, k = e & 63;
        float S = 0.f;
        for (int i0 = 0; i0 < 260; i0 += 13) {
            float Lc[13], Dc[13];
#pragma unroll
            for (int j = 0; j < 13; ++j) { const int i = i0 + j; const int R = dir == 0 ? (i < 4 ? 256 + i : i - 4) : 259 - i; const size_t idx = (size_t)(R * 8 + hh) * 2 + dir;
                Lc[j] = HG[idx * 4096 + vk]; Dc[j] = HGD[idx * 64 + k]; }
            __builtin_amdgcn_sched_barrier(0);
#pragma unroll
            for (int j = 0; j < 13; ++j) { const int i = i0 + j; const int R = dir == 0 ? (i < 4 ? 256 + i : i - 4) : 259 - i; const size_t idx = (size_t)(R * 8 + hh) * 2 + dir;
                HGo[(second ? (idx & 255) : idx) * 4096 + vk] = S; S = Dc[j] * S + Lc[j]; }
        }
    }
}
DI void phase_hgrn3(const Params& P, LAS unsigned char* lds, int tid, int wave, int lane) {
    const bf16_t* proj = (const bf16_t*)(P.ws + WS_PROJCD); const float* HG = (const float*)(P.ws + WS_HG); bf16_t* H = (bf16_t*)(P.ws + WS_H);
    constexpr int MB = 64 * HS;
    LAS unsigned char* Qg = lds; LAS unsigned char* Kg = lds + 2 * MB; LAS unsigned char* Sg = lds + 4 * MB; LAS unsigned char* VTl = lds + 6 * MB;
    LAS float* Os = (LAS float*)(lds + 7 * MB); LAS float* segtot = Os + 64 * 65; LAS float* gmids = segtot + 512;
    const int r32 = lane & 31, h = lane >> 5;
    for (int it = blockIdx.x; it < 256 * 8; it += gridDim.x) {
        const int R = it >> 3, hh = it & 7, rowbase = R * 64;
        float gc[16], kin[16], gtot, gmid;
        bf16_t rqv[16];
        { const int seg_ = (tid >> 6) & 3, k_ = tid & 63;
#pragma unroll
          for (int j = 0; j < 16; ++j) rqv[j] = proj[(size_t)(rowbase + 16 * seg_ + j) * CDP + hh * 64 + k_]; }
        const u32x4 vw = *(const u32x4*)(proj + (size_t)(rowbase + (tid >> 3)) * CDP + 1536 + hh * 64 + (tid & 7) * 8);
        const u32x4 gw = *(const u32x4*)(proj + (size_t)(rowbase + (tid >> 3)) * CDP + 2048 + hh * 64 + (tid & 7) * 8);
        f32x4 sa[2], sb[2];
#pragma unroll
        for (int d = 0; d < 2; ++d) { const float* sp = HG + ((size_t)(R * 8 + hh) * 2 + d) * 4096 + (tid >> 3) * 64 + (tid & 7) * 8; sa[d] = *(const f32x4*)sp; sb[d] = *(const f32x4*)(sp + 4); }
        hgrn_gates(P, proj, rowbase, hh, tid, segtot, gmids, gc, kin, gtot, gmid);
        const int dir = tid >> 8, seg = (tid >> 6) & 3, k = tid & 63;
#pragma unroll
        for (int j = 0; j < 16; ++j) { const int t = 16 * seg + j; const float q = silu(bf2f(rqv[j]));
            *(LAS bf16_t*)(Qg + (dir * 64 + t) * HS + 2 * k) = f2bf(q * __expf(fminf(gc[j] - gmid, 80.f)));
            *(LAS bf16_t*)(Kg + (dir * 64 + t) * HS + 2 * k) = f2bf(kin[j] * __expf(fminf(gmid - gc[j], 80.f))); }
        { const int s = tid >> 3, v8 = (tid & 7) * 8; const u32x4 w = vw;
          const unsigned ww[4] = {w.x, w.y, w.z, w.w}; const int sp = swap23(s);
#pragma unroll
          for (int i = 0; i < 8; ++i) *(LAS bf16_t*)(VTl + (v8 + i) * HS + 2 * sp) = (bf16_t)((ww[i >> 1] >> ((i & 1) * 16)) & 0xffffu); }
#pragma unroll
        for (int d = 0; d < 2; ++d) { const int v = tid >> 3, k8 = (tid & 7) * 8;
            const f32x4 a = sa[d], b = sb[d]; const LAS float* gm = gmids + d * 64 + k8;
            u32x4 w; w.x = pk2(a.x * __expf(gm[0]), a.y * __expf(gm[1])); w.y = pk2(a.z * __expf(gm[2]), a.w * __expf(gm[3])); w.z = pk2(b.x * __expf(gm[4]), b.y * __expf(gm[5])); w.w = pk2(b.z * __expf(gm[6]), b.w * __expf(gm[7]));
            *(LAS u32x4*)(Sg + (d * 64 + v) * HS + 2 * k8) = w; }
        __syncthreads();
        const int wd = wave >> 2, tb = (wave >> 1) & 1, vb = wave & 1;
        f32x16 acc;
        { f32x16 p0, p1;
#pragma unroll
          for (int r = 0; r < 16; ++r) { p0[r] = 0.f; p1[r] = 0.f; acc[r] = 0.f; }
          const LAS unsigned char* kp = Kg + (wd * 64 + r32) * HS + 16 * h; const LAS unsigned char* qp = Qg + (wd * 64 + 32 * tb + r32) * HS + 16 * h;
          bf16x8 qf[4];
#pragma unroll
          for (int ks = 0; ks < 4; ++ks) qf[ks] = *(const LAS bf16x8*)(qp + 32 * ks);
#pragma unroll
          for (int ks = 0; ks < 4; ++ks) { p0 = MFMA32(*(const LAS bf16x8*)(kp + 32 * ks), qf[ks], p0); p1 = MFMA32(*(const LAS bf16x8*)(kp + 32 * HS + 32 * ks), qf[ks], p1); }
          const int t = 32 * tb + r32;
#pragma unroll
          for (int r = 0; r < 16; ++r) { const int s0 = (r & 3) + 8 * (r >> 2) + 4 * h, s1 = s0 + 32;
              const bool ok0 = wd == 0 ? (s0 <= t) : (s0 >= t), ok1 = wd == 0 ? (s1 <= t) : (s1 >= t); p0[r] = ok0 ? p0[r] : 0.f; p1[r] = ok1 ? p1[r] : 0.f; }
          bf16x8 pb[4]; pb[0] = pack8(p0, 0); pb[1] = pack8(p0, 8); pb[2] = pack8(p1, 0); pb[3] = pack8(p1, 8);
          const LAS unsigned char* vp = VTl + (32 * vb + r32) * HS + 16 * h; const LAS unsigned char* sp = Sg + (wd * 64 + 32 * vb + r32) * HS + 16 * h;
#pragma unroll
          for (int ks = 0; ks < 4; ++ks) { acc = MFMA32(*(const LAS bf16x8*)(vp + 32 * ks), pb[ks], acc); acc = MFMA32(*(const LAS bf16x8*)(sp + 32 * ks), qf[ks], acc); } }
        { const int t = 32 * tb + r32;
          if (wd == 0) {
#pragma unroll
              for (int r = 0; r < 16; ++r) Os[t * 65 + 32 * vb + (r & 3) + 8 * (r >> 2) + 4 * h] = acc[r]; }
          __syncthreads();
          if (wd == 1) {
#pragma unroll
              for (int r = 0; r < 16; ++r) Os[t * 65 + 32 * vb + (r & 3) + 8 * (r >> 2) + 4 * h] += acc[r]; }
          __syncthreads(); }
        { const int t = tid >> 3, v8 = (tid & 7) * 8; float o[8]; float ss = 0.f;
#pragma unroll
          for (int i = 0; i < 8; ++i) { o[i] = Os[t * 65 + v8 + i]; ss += o[i] * o[i]; }
          ss += SHX(ss, 1); ss += SHX(ss, 2); ss += SHX(ss, 4);
          const float rs = rsqrtf(ss * (1.f / 64.f) + EPS);
          const unsigned gg[4] = {gw.x, gw.y, gw.z, gw.w};
          float y[8];
#pragma unroll
          for (int i = 0; i < 8; ++i) { const float gate = __uint_as_float(((gg[i >> 1] >> ((i & 1) * 16)) & 0xffffu) << 16); y[i] = o[i] * rs * P.in[20][v8 + i] * silu(gate); }
          u32x4 w; w.x = pk2(y[0], y[1]); w.y = pk2(y[2], y[3]); w.z = pk2(y[4], y[5]); w.w = pk2(y[6], y[7]);
          *(u32x4*)(H + (size_t)(rowbase + t) * DM + hh * 64 + v8) = w; }
        __syncthreads();
    }
}

DI void gemm_up(const Params& P, LAS unsigned char* lds, int slot, int M, int tid) {
    pg8::Gemm g{(const bf16_t*)(P.ws + WS_H), (const bf16_t*)(P.ws + WS_FFN0 + slot * FFN_SLOT), M, 2 * FF, DM, DM};
    pg8::StaticOrder S; S.init(M, 2 * FF, gridDim.x, blockIdx.x);
    pg8::EpiSwiglu E{(bf16_t*)(P.ws + WS_U), FF};
    pg8::gemm_phase<pg8::EpiSwiglu, pg8::StaticOrder, true, true>(lds, g, S, E, tid);
}
DI void gemm_res(const Params& P, LAS unsigned char* lds, const bf16_t* A, const bf16_t* Bt, int M, int K, bool first, const float* coefL, const float* coefC, float mult, int tid) {
    float* xc = (float*)(P.ws + WS_XC);
    {
        pg8::Gemm g{A, Bt, SEQ, DM, K, K};
        pg8::StaticOrder S; S.init(SEQ, DM, gridDim.x, blockIdx.x);
        pg8::EpiResidual E{first ? P.in[0] : (const float*)P.out, nullptr, P.out, nullptr, coefL, nullptr, mult};
        pg8::gemm_phase<pg8::EpiResidual, pg8::StaticOrder, true, true>(lds, g, S, E, tid);
    }
    if (M > SEQ) {
        const int nsplit = K / 256, c = blockIdx.x, ks = c >> 2;
        pg8::Gemm g{A + (size_t)SEQ * K + ks * 256, Bt + ks * 256, CTX, DM, 256, K};
        pg8::OneUnitOrder S{c, 4 * nsplit};
        pg8::EpiPartCtx E{(float*)(P.ws + WS_PART) + (size_t)ks * CTX * DM, coefC, mult};
        pg8::gemm_phase<pg8::EpiPartCtx, pg8::OneUnitOrder, true, true>(lds, g, S, E, tid);
    }
}
DI void gemm_store(const Params& P, LAS unsigned char* lds, const bf16_t* Bt, int N, bf16_t* O, int tid) {
    pg8::Gemm g{(const bf16_t*)(P.ws + WS_H), Bt, MT, N, DM, DM};
    pg8::StaticOrder S; S.init(MT, N, gridDim.x, blockIdx.x);
    pg8::EpiStoreBf16 E{O, N};
    pg8::gemm_phase<pg8::EpiStoreBf16, pg8::StaticOrder, true, true>(lds, g, S, E, tid);
}
#define XB_TMO      128
#define XB_XCNT(j)  (256  + 64 * (j))
#define XB_XSUB(j)  (1280 + 64 * (j))
#define XB_XGEN(j)  (2304 + 64 * (j))
#define XB_TOP      3328
#define XB_TOPGEN   3392
#define XCD_BAR_WORDS 3456
#define XB_SPIN_CAP (1u << 18)

__device__ __forceinline__ unsigned xb_ld(unsigned* p)              { return __hip_atomic_load(p, __ATOMIC_RELAXED, __HIP_MEMORY_SCOPE_AGENT); }
__device__ __forceinline__ unsigned xb_add(unsigned* p, unsigned v) { return __hip_atomic_fetch_add(p, v, __ATOMIC_RELAXED, __HIP_MEMORY_SCOPE_AGENT); }
__device__ __forceinline__ unsigned xb_xcc_id() { return (unsigned)__builtin_amdgcn_s_getreg((3 << 11) | 20) & 0xFu; }
#define XB_SPIN(cond, bar) do { unsigned _sp = 0; while (cond) { __builtin_amdgcn_s_sleep(1); \
    if ((++_sp & 255u) == 0u) { if (xb_ld(&(bar)[XB_TMO])) break; if (_sp > XB_SPIN_CAP) { atomicAdd(&(bar)[XB_TMO], 1u); break; } } } } while (0)

struct XcdBarrier {
    unsigned* bar; unsigned x;
    volatile LAS unsigned* st;
};

__device__ __forceinline__ XcdBarrier xcd_barrier_post(unsigned* bar, volatile LAS unsigned* st) {
    XcdBarrier b; b.bar = bar; b.x = xb_xcc_id(); b.st = st;
    if (threadIdx.x == 0) (void)xb_add(&bar[XB_XCNT(b.x)], 1u);
    return b;
}
__device__ __forceinline__ void xcd_barrier_complete(unsigned* bar, unsigned x, unsigned& nloc, unsigned& nx) {
    const unsigned G = gridDim.x * gridDim.y * gridDim.z;
    unsigned sum, cnt, mine, sp = 0u;
    for (;;) {
        sum = 0u; cnt = 0u; mine = 0u;
#pragma unroll
        for (unsigned j = 0; j < 16; ++j) { const unsigned c = xb_ld(&bar[XB_XCNT(j)]); sum += c; cnt += (c > 0u) ? 1u : 0u; mine = (j == x) ? c : mine; }
        if (sum == G) break;
        __builtin_amdgcn_s_sleep(1);
        if ((++sp & 255u) == 0u) { if (xb_ld(&bar[XB_TMO])) break; if (sp > XB_SPIN_CAP) { atomicAdd(&bar[XB_TMO], 1u); break; } }
    }
    nloc = mine > 0u ? mine : 1u; nx = cnt > 0u ? cnt : 1u;
}

__device__ __forceinline__ void xcd_barrier(const XcdBarrier& b) {
    asm volatile("s_waitcnt vmcnt(0)" ::: "memory");
    __syncthreads();
    if (threadIdx.x == 0) {
        unsigned* bar = b.bar;
        __builtin_amdgcn_s_waitcnt(0);
        unsigned nloc = b.st[0], nx = b.st[1];
        if (nloc == 0u) { xcd_barrier_complete(bar, b.x, nloc, nx); b.st[0] = nloc; b.st[1] = nx; }
        const unsigned old = xb_add(&bar[XB_XSUB(b.x)], 1u);
        const unsigned gen = old / nloc;
        if (old + 1u == (gen + 1u) * nloc) {
            __builtin_amdgcn_fence(__ATOMIC_RELEASE, "agent");
            asm volatile("s_waitcnt vmcnt(0)" ::: "memory");
            const unsigned og = xb_add(&bar[XB_TOP], 1u);
            const unsigned tg = og / nx;
            if (og + 1u == (tg + 1u) * nx) xb_add(&bar[XB_TOPGEN], 1u);
            else XB_SPIN(xb_ld(&bar[XB_TOPGEN]) == tg, bar);
            __builtin_amdgcn_fence(__ATOMIC_ACQUIRE, "agent");
            xb_add(&bar[XB_XGEN(b.x)], 1u);
            asm volatile("s_waitcnt vmcnt(0)" ::: "memory");
        } else {
            XB_SPIN(xb_ld(&bar[XB_XGEN(b.x)]) == gen, bar);
            __builtin_amdgcn_fence(__ATOMIC_ACQUIRE, "agent");
            asm volatile("s_waitcnt vmcnt(0)" ::: "memory");
        }
    }
    __syncthreads();
}

enum { K_PRO = 0, K_NORM, K_UP, K_RES, K_STORE, K_POSTAB, K_ATTN, K_POSTCD, K_MIX1, K_MIX2 };
__global__ void __launch_bounds__(512, 2) mega(Params P0) {
    extern __shared__ __attribute__((aligned(16))) unsigned char lds_raw[];
    LAS unsigned char* lds = (LAS unsigned char*)lds_raw;
    cg::grid_group grid = cg::this_grid();
    const int wave_s = __builtin_amdgcn_readfirstlane(threadIdx.x >> 6);
    volatile LAS unsigned* barst = (volatile LAS unsigned*)(lds + LDS_BARST);
    if (threadIdx.x < 2) barst[threadIdx.x] = 0u;
    __syncthreads();
    (void)xcd_barrier_post((unsigned*)(P0.ws + WS_BAR), barst);
    for (int step = P0.ph_lo; step < P0.ph_hi; ++step) {
        Params P = P0;
        { __attribute__((address_space(1))) unsigned char* g_ = (__attribute__((address_space(1))) unsigned char*)P0.ws; asm volatile("" : "+s"(g_)); P.ws = (unsigned char*)g_; }
        { __attribute__((address_space(1))) float* g_ = (__attribute__((address_space(1))) float*)P0.out; asm volatile("" : "+s"(g_)); P.out = (float*)g_; }
#pragma unroll
        for (int i_ = 0; i_ < 25; ++i_) { const __attribute__((address_space(1))) float* g_ = (const __attribute__((address_space(1))) float*)P0.in[i_]; asm volatile("" : "+s"(g_)); P.in[i_] = (const float*)g_; }
#ifdef DUP_PH
        const int ph = step <= DUP_PH ? step : step - 1;
        const bool second = step == DUP_PH + 1;
#else
        const int ph = step; const bool second = false;
#endif
        int lane; asm volatile("v_mbcnt_lo_u32_b32 %0, -1, 0\n\tv_mbcnt_hi_u32_b32 %0, -1, %0" : "=v"(lane));
        const int wave = wave_s, tid = wave * 64 + lane;
        const float* modx = (const float*)(P.ws + WS_MODX); const float* modc = (const float*)(P.ws + WS_MODC);
        const int l = ph >= 12 ? 1 : 0;
        const int M = ph >= 20 ? SEQ : MT;
        int kind;
        switch (ph) {
        case 0: kind = K_PRO; break;
        case 1: case 4: case 9: case 12: case 15: case 21: kind = K_NORM; break;
        case 2: case 10: case 13: case 22: kind = K_UP; break;
        case 3: case 8: case 11: case 14: case 20: case 23: kind = K_RES; break;
        case 5: case 16: kind = K_STORE; break;
        case 6: kind = K_POSTAB; break;
        case 7: kind = K_ATTN; break;
        case 17: kind = K_POSTCD; break;
        case 18: kind = K_MIX1; break;
        default: kind = K_MIX2; break;
        }
        if (kind == K_PRO) phase_prologue(P, lds, tid, wave, lane, second);
        else if (kind == K_NORM) {
            const int idx = (ph == 1 || ph == 12) ? 0 : ((ph == 4 || ph == 15) ? 1 : 2);
            phase_normmod(P, l, idx, ph == 1, M, (ph == 1 || ph == 21) ? 0 : (ph == 9 ? 4 : 11), wave, lane);
            if (ph == 4 || ph == 21) { LAS float* scr = (LAS float*)(lds + wave * 16384); const int j = ph == 4 ? 0 : 1;
                for (int it = blockIdx.x * 8 + wave; it < FFN_ITEMS; it += gridDim.x * 8) convert_ffn_item(P, 1, j, j, it, scr, lane); }
        }
        else if (kind == K_UP) gemm_up(P, lds, (ph == 10 || ph == 22) ? 1 : 0, M, tid);
        else if (kind == K_RES) {
            const bool ffn = !(ph == 8 || ph == 20); const int slot = (ph == 11 || ph == 23) ? 1 : 0; const int ci = ffn ? (slot ? 8 : 2) : 5;
            const bf16_t* A = ffn ? (const bf16_t*)(P.ws + WS_U) : (const bf16_t*)(P.ws + WS_H);
            const bf16_t* Bt = ffn ? (const bf16_t*)(P.ws + WS_FFN0 + slot * FFN_SLOT + FFN_W2OFF) : (const bf16_t*)(P.ws + (ph == 8 ? WS_WOUTAB : WS_WOUTCD));
            gemm_res(P, lds, A, Bt, M, ffn ? FF : DM, ph == 3, modx + l * 9216 + ci * DM, modc + l * 9216 + ci * DM, ffn ? 0.5f : 1.0f, tid);
        }
        else if (kind == K_STORE) { if (ph == 5) gemm_store(P, lds, (const bf16_t*)(P.ws + WS_WINAB), ABP, (bf16_t*)(P.ws + WS_PROJAB), tid);
                                    else gemm_store(P, lds, (const bf16_t*)(P.ws + WS_WINCD), CDP, (bf16_t*)(P.ws + WS_PROJCD), tid); }
        else if (kind == K_POSTAB) phase_postAB(P, lds, tid, wave, lane, second);
        else if (kind == K_ATTN) phase_attn(P, lds, tid, wave, lane, second);
        else if (kind == K_POSTCD) {
#ifdef PROBE_ALT
            phase_postCD(P, lds, tid, wave, lane, second); if (!second) phase_hgrn1(P, lds, tid, wave, lane);
#else
            if (!second) phase_postCD(P, lds, tid, wave, lane, false); phase_hgrn1(P, lds, tid, wave, lane);
#endif
        }
        else if (kind == K_MIX1) {
#ifdef PROBE_ALT
            phase_hgrn2(P, tid, second); if (!second) phase_na(P, lds, tid, wave, lane);
#else
            if (!second) phase_hgrn2(P, tid, false); phase_na(P, lds, tid, wave, lane);
#endif
        }
        else phase_hgrn3(P, lds, tid, wave, lane);
        if (step + 1 < P.ph_hi) { if (P0.ph_hi < 0) grid.sync();   { XcdBarrier xb_; xb_.bar = (unsigned*)(P.ws + WS_BAR); xb_.x = xb_xcc_id(); xb_.st = (volatile LAS unsigned*)(lds + LDS_BARST); xcd_barrier(xb_); } }
    }
}

extern "C" void kernel_launch(void* const* d_in, const int* in_sizes, int n_in, void* d_out, int out_size, void* d_ws, size_t ws_size, hipStream_t stream) {
    static int grid = 0;
    if (grid == 0) {
        if (n_in != 25 || out_size != SEQ * DM || ws_size < WS_END) { fprintf(stderr, "kernel_launch: unexpected shapes n_in %d out %d ws %zu\n", n_in, out_size, ws_size); grid = -1; return; }
        int dev = 0, cus = 0, per_cu = 0;
        hipGetDevice(&dev); hipDeviceGetAttribute(&cus, hipDeviceAttributeMultiprocessorCount, dev);
        if (hipFuncSetAttribute((const void*)mega, hipFuncAttributeMaxDynamicSharedMemorySize, LDS_BYTES) != hipSuccess) { fprintf(stderr, "hipFuncSetAttribute failed\n"); grid = -1; return; }
        hipOccupancyMaxActiveBlocksPerMultiprocessor(&per_cu, (const void*)mega, 512, LDS_BYTES);
        if (per_cu < 1) { fprintf(stderr, "occupancy query says %d\n", per_cu); per_cu = 1; }
        (void)hipGetLastError();
        grid = cus;
    }
    if (grid < 0) return;
    hipMemsetAsync((char*)d_ws, 0, CTL_ZERO_BYTES, stream);
    Params p{};
    for (int i = 0; i < 25; ++i) p.in[i] = (const float*)d_in[i];
    p.out = (float*)d_out; p.ws = (unsigned char*)d_ws;
#if N_LAUNCH_MODE == 1
    for (int ph = 0; ph < NPH; ++ph) { p.ph_lo = ph; p.ph_hi = ph + 1; hipLaunchKernelGGL(mega, dim3(grid), dim3(512), LDS_BYTES, stream, p); }
#else
    p.ph_lo = 0; p.ph_hi = NPH;
    void* args[] = {&p};
    hipError_t e = hipLaunchCooperativeKernel((const void*)mega, dim3(grid), dim3(512), args, LDS_BYTES, stream);
    if (e != hipSuccess) fprintf(stderr, "cooperative launch failed: %s (grid %d)\n", hipGetErrorString(e), grid);
#endif
}
```
